# Optimizing an MI355X kernel written in HIP

```python
import math
import jax, jax.numpy as jnp
from jax import lax
import numpy as np

D_MODEL = 1024
BATCH = 8
SEQ = 4096
DEPTH = 1

CHUNK = 64
Q_BLOCK = 128
D_MIX = D_MODEL
MLA_HEADS = 8
NOPE_DIM = 64
ROPE_DIM = 32
V_DIM = 64
Q_LORA = 256
KV_LORA = 128
ROPE_THETA = 10000.0
MLA_WIDTH = MLA_HEADS * V_DIM
ATTN_SCALE = (NOPE_DIM + ROPE_DIM) ** -0.5
GM_HEADS = 8
GM_DIM = 64
GM_CHUNK = 128
GM_WIDTH = GM_HEADS * GM_DIM
IN_COLS = Q_LORA + KV_LORA + ROPE_DIM + 2 * GM_WIDTH
D_FF = 2816
CONV_W = 3
EPS = 1e-6

kernel_name = "hybrid_mla_gmlp_convffn_block"


def rms_norm(x, g):
    x32 = x.astype(jnp.float32)
    y = x32 * lax.rsqrt(jnp.mean(x32 * x32, axis=-1, keepdims=True) + EPS)
    return (y * g.astype(jnp.float32)).astype(x.dtype)


def layer_norm(x, g, b):
    x32 = x.astype(jnp.float32)
    mu = jnp.mean(x32, axis=-1, keepdims=True)
    var = jnp.mean(jnp.square(x32 - mu), axis=-1, keepdims=True)
    y = (x32 - mu) * lax.rsqrt(var + EPS)
    return (y * g.astype(jnp.float32) + b.astype(jnp.float32)).astype(x.dtype)


def modulate(h, shift, scale):
    return h * (1.0 + scale[:, None, :]) + shift[:, None, :]


def rope_tables(seq):
    pos = jnp.arange(seq, dtype=jnp.float32)
    inv = ROPE_THETA ** (-jnp.arange(0, ROPE_DIM, 2, dtype=jnp.float32) / ROPE_DIM)
    ang = pos[:, None] * inv[None, :]
    return jnp.cos(ang), jnp.sin(ang)


def apply_rope(t, cos, sin):
    t32 = t.astype(jnp.float32)
    t1, t2 = jnp.split(t32, 2, axis=-1)
    out = jnp.concatenate([t1 * cos - t2 * sin, t2 * cos + t1 * sin], axis=-1)
    return out.astype(t.dtype)


def mla_attention(q_nope, q_rope, k_nope, k_rope, v):
    B, S, H, _ = q_nope.shape
    nb = S // Q_BLOCK
    k_chunk = jnp.arange(S) // CHUNK

    def to_blocks(t):
        return t.reshape((B, nb, Q_BLOCK) + t.shape[2:]).swapaxes(0, 1)

    def one_block(args):
        qn, qr, bi = args
        s = (jnp.einsum('bqhd,bkhd->bhqk', qn, k_nope)
             + jnp.einsum('bqhr,bkr->bhqk', qr, k_rope))
        s = s.astype(jnp.float32) * ATTN_SCALE
        q_chunk = (bi * Q_BLOCK + jnp.arange(Q_BLOCK)) // CHUNK
        mask = k_chunk[None, :] <= q_chunk[:, None]
        s = jnp.where(mask[None, None], s, -jnp.inf)
        p = jax.nn.softmax(s, axis=-1).astype(v.dtype)
        return jnp.einsum('bhqk,bkhd->bqhd', p, v)

    o = lax.map(one_block, (to_blocks(q_nope), to_blocks(q_rope), jnp.arange(nb)))
    return o.swapaxes(0, 1).reshape(B, S, H * V_DIM)


def gmlp_spatial_gate(u, v, ln_g, ln_b, w_s, b_s):
    B, S, H, Dh = v.shape
    v = layer_norm(v, ln_g, ln_b)
    idx = jnp.arange(GM_CHUNK) // CHUNK
    mask = (idx[None, :] <= idx[:, None]).astype(w_s.dtype)
    w_m = w_s * mask[None]
    vb = v.reshape(B, S // GM_CHUNK, GM_CHUNK, H, Dh)
    mixed = jnp.einsum('hij,bnjhd->bnihd', w_m, vb) + b_s.T[None, None, :, :, None]
    return u * mixed.reshape(B, S, H, Dh)


def token_mixer(h, w_in, g_q, w_uq, g_kv, w_ukv, gm_ln_g, gm_ln_b, w_spatial, b_spatial, w_out):
    B, S, _ = h.shape
    z = h @ w_in
    o1 = Q_LORA
    o2 = o1 + KV_LORA
    o3 = o2 + ROPE_DIM
    c_q, c_kv, k_r, g_uv = z[..., :o1], z[..., o1:o2], z[..., o2:o3], z[..., o3:]
    q = (rms_norm(c_q, g_q) @ w_uq).reshape(B, S, MLA_HEADS, NOPE_DIM + ROPE_DIM)
    kv = (rms_norm(c_kv, g_kv) @ w_ukv).reshape(B, S, MLA_HEADS, NOPE_DIM + V_DIM)
    q_nope, q_rope = q[..., :NOPE_DIM], q[..., NOPE_DIM:]
    k_nope, v = kv[..., :NOPE_DIM], kv[..., NOPE_DIM:]
    cos, sin = rope_tables(S)
    q_rope = apply_rope(q_rope, cos[None, :, None, :], sin[None, :, None, :])
    k_rope = apply_rope(k_r, cos[None], sin[None])
    attn = mla_attention(q_nope, q_rope, k_nope, k_rope, v)
    g = jax.nn.gelu(g_uv)
    u = g[..., :GM_WIDTH].reshape(B, S, GM_HEADS, GM_DIM)
    vv = g[..., GM_WIDTH:].reshape(B, S, GM_HEADS, GM_DIM)
    sgu = gmlp_spatial_gate(u, vv, gm_ln_g, gm_ln_b, w_spatial, b_spatial).reshape(B, S, GM_WIDTH)
    return jnp.concatenate([attn, sgu], axis=-1) @ w_out


def conv_ffn(h, w_up, conv_w, conv_b, w_down):
    S = h.shape[1]
    up = h @ w_up
    upp = jnp.pad(up, ((0, 0), (CONV_W - 1, 0), (0, 0)))
    y = conv_b + sum(upp[:, k:k + S, :] * conv_w[k] for k in range(CONV_W))
    a, b = y[..., :D_FF], y[..., D_FF:]
    return (jax.nn.silu(a) * b) @ w_down


def setup_inputs(seed: int = 0) -> dict:
    key = jax.random.key(seed)
    ks = jax.random.split(key, 24)
    f32 = jnp.float32
    n = lambda k, shape, s: jax.random.normal(k, shape, f32) * s
    gain = lambda k, shape: 1.0 + 0.05 * jax.random.normal(k, shape, f32)
    L = DEPTH
    return {
        "x": jax.random.normal(ks[0], (BATCH, SEQ, D_MODEL), f32),
        "c": jax.random.normal(ks[1], (BATCH, D_MODEL), f32),
        "w_ada": n(ks[2], (L, D_MODEL, 6 * D_MODEL), 0.5 * D_MODEL ** -0.5),
        "b_ada": n(ks[3], (L, 6 * D_MODEL), 0.02),
        "g_pre_mix": gain(ks[4], (L, D_MODEL)),
        "g_post_mix": gain(ks[5], (L, D_MODEL)),
        "w_in": n(ks[6], (L, D_MODEL, IN_COLS), D_MODEL ** -0.5),
        "g_q": gain(ks[7], (L, Q_LORA)),
        "w_uq": n(ks[8], (L, Q_LORA, MLA_HEADS * (NOPE_DIM + ROPE_DIM)), Q_LORA ** -0.5),
        "g_kv": gain(ks[9], (L, KV_LORA)),
        "w_ukv": n(ks[10], (L, KV_LORA, MLA_HEADS * (NOPE_DIM + V_DIM)), KV_LORA ** -0.5),
        "gm_ln_g": gain(ks[11], (L, GM_HEADS, GM_DIM)),
        "gm_ln_b": n(ks[12], (L, GM_HEADS, GM_DIM), 0.02),
        "w_spatial": n(ks[13], (L, GM_HEADS, GM_CHUNK, GM_CHUNK), GM_CHUNK ** -0.5),
        "b_spatial": 1.0 + n(ks[14], (L, GM_HEADS, GM_CHUNK), 0.05),
        "w_out": n(ks[15], (L, D_MIX, D_MODEL), D_MIX ** -0.5),
        "g_pre_ffn": gain(ks[16], (L, D_MODEL)),
        "g_post_ffn": gain(ks[17], (L, D_MODEL)),
        "w_up": n(ks[18], (L, D_MODEL, 2 * D_FF), D_MODEL ** -0.5),
        "conv_w": n(ks[19], (L, CONV_W, 2 * D_FF), CONV_W ** -0.5),
        "conv_b": n(ks[20], (L, 2 * D_FF), 0.02),
        "w_down": n(ks[21], (L, D_FF, D_MODEL), D_FF ** -0.5),
    }


def reference(x, c, w_ada, b_ada, g_pre_mix, g_post_mix, w_in, g_q, w_uq, g_kv, w_ukv,
              gm_ln_g, gm_ln_b, w_spatial, b_spatial, w_out, g_pre_ffn, g_post_ffn,
              w_up, conv_w, conv_b, w_down):
    c_act = jax.nn.silu(c)
    for l in range(DEPTH):
        ada = c_act @ w_ada[l] + b_ada[l]
        sh1, sc1, gt1, sh2, sc2, gt2 = jnp.split(ada, 6, axis=-1)
        h = modulate(rms_norm(x, g_pre_mix[l]), sh1, sc1)
        m = token_mixer(h, w_in[l], g_q[l], w_uq[l], g_kv[l], w_ukv[l], gm_ln_g[l], gm_ln_b[l],
                        w_spatial[l], b_spatial[l], w_out[l])
        x = x + gt1[:, None, :] * rms_norm(m, g_post_mix[l])
        h = modulate(rms_norm(x, g_pre_ffn[l]), sh2, sc2)
        f = conv_ffn(h, w_up[l], conv_w[l], conv_b[l], w_down[l])
        x = x + gt2[:, None, :] * rms_norm(f, g_post_ffn[l])
    return x
```

```cpp
#define PROBE 0
#include <hip/hip_runtime.h>
#include <hip/hip_cooperative_groups.h>
#include <cstdio>
#include <cstdint>
namespace cg = cooperative_groups;
#ifndef PROBE
#define PROBE 0
#endif
#if PROBE == 1
#define GSYNC() do { xcd_barrier(xbar); xcd_barrier(xbar); } while (0)
#else
#define GSYNC() xcd_barrier(xbar)
#endif

#define LAS __attribute__((address_space(3)))
typedef unsigned short bf16_t;
typedef short bf16x8 __attribute__((ext_vector_type(8)));
typedef float f32x4 __attribute__((ext_vector_type(4)));
typedef float f32x16 __attribute__((ext_vector_type(16)));
typedef unsigned u32x4 __attribute__((ext_vector_type(4)));
typedef unsigned u32x2 __attribute__((ext_vector_type(2)));
typedef float f32x2_t __attribute__((ext_vector_type(2)));
typedef __bf16 bf16x2_t __attribute__((ext_vector_type(2)));

__device__ __forceinline__ unsigned pk2(float lo, float hi) { f32x2_t v = {lo, hi}; bf16x2_t b = __builtin_convertvector(v, bf16x2_t); return __builtin_bit_cast(unsigned, b); }
__device__ __forceinline__ float bf_lo(unsigned u) { return __uint_as_float(u << 16); }
__device__ __forceinline__ float bf_hi(unsigned u) { return __uint_as_float(u & 0xffff0000u); }
__device__ __forceinline__ float wave_sum(float v) {
#pragma unroll
    for (int o = 1; o < 64; o <<= 1) v += __shfl_xor(v, o);
    return v;
}
__device__ __forceinline__ float gelu_tanh(float x) {
    const float t = x * (1.0f + 0.044715f * x * x);
    const float e = __builtin_amdgcn_exp2f(-2.0f * 0.7978845608028654f * 1.4426950408889634f * t);
    return x * __builtin_amdgcn_rcpf(1.0f + e);
}
__device__ __forceinline__ float silu_f(float x) { return x * __builtin_amdgcn_rcpf(1.0f + __builtin_amdgcn_exp2f(-1.4426950408889634f * x)); }

constexpr int NB = 8, SEQ = 4096, DM = 1024, MTOK = NB * SEQ;
constexpr int NZ = 1536;
constexpr int QL = 256, KVL = 128, NQ = 768, NKN = 512, DFF = 2816, NUP = 5632;
constexpr float EPS = 1e-6f;
constexpr float C2 = 0.10206207261596575f * 1.4426950408889634f;

constexpr size_t MiB = 1u << 20;
constexpr size_t WS_ADA = 0;
constexpr size_t CTL_ZERO_BYTES = 512 * 1024;
constexpr size_t WS_CNT = 256 * 1024;
constexpr size_t WS_GV = 1 * MiB + 768 * 1024;
constexpr size_t WS_XB = 25 * MiB;
constexpr size_t WS_BAR = 200 * 1024;
constexpr size_t WS_ROPE = 1 * MiB;
constexpr size_t WS_WSP = 1 * MiB + 512 * 1024;
constexpr size_t WS_WIN = 2 * MiB;
constexpr size_t WS_WUQ = 5 * MiB;
constexpr size_t WS_WUK = 5 * MiB + 512 * 1024;
constexpr size_t WS_WUV = 5 * MiB + 768 * 1024;
constexpr size_t WS_WO = 6 * MiB;
constexpr size_t WS_WUP = 8 * MiB;
constexpr size_t WS_WDN = 19 * MiB;
constexpr size_t WS_XN = 32 * MiB;
constexpr size_t WS_Z = 96 * MiB;
constexpr size_t WS_CQN = 192 * MiB;
constexpr size_t WS_CKVN = 208 * MiB;
constexpr size_t WS_KR = 216 * MiB;
constexpr size_t WS_Q = 218 * MiB;
constexpr size_t WS_KN = 266 * MiB;
constexpr size_t WS_VT = 298 * MiB;
constexpr size_t WS_AO = 330 * MiB;
constexpr size_t WS_MB = 394 * MiB;
constexpr size_t WS_SIDE = 96 * MiB;
constexpr size_t WS_ACT = 272 * MiB;
constexpr size_t WS_FB = 448 * MiB;
constexpr size_t WS_END = 512 * MiB;

constexpr int LDS_BYTES = 147456;

struct Args {
    const float* x; const float* c; const float* w_ada; const float* b_ada; const float* g_pre_mix; const float* g_post_mix;
    const float* w_in; const float* g_q; const float* w_uq; const float* g_kv; const float* w_ukv; const float* gm_ln_g; const float* gm_ln_b;
    const float* w_spatial; const float* b_spatial; const float* w_out; const float* g_pre_ffn; const float* g_post_ffn;
    const float* w_up; const float* conv_w; const float* conv_b; const float* w_down;
    float* out; unsigned char* ws;
};

#define CAS __attribute__((address_space(4)))
__device__ __forceinline__ const CAS Args* kargs() { const CAS void* p = (const CAS void*)__builtin_amdgcn_kernarg_segment_ptr(); asm volatile("" : "+s"(p)); return (const CAS Args*)p; }
#define KARGS() const CAS Args* KA = kargs()
__device__ __forceinline__ int otid() { int t = threadIdx.x; asm volatile("" : "+v"(t)); return t; }

namespace pg8 {
#define PG8_LAS __attribute__((address_space(3)))
constexpr int BM = 256, BK = 64, HALF = 128, HTB = HALF * BK * 2, STAGE_BYTES = 8 * HTB, NXCD = 8, WGM = 2;
__host__ __device__ __forceinline__ int lds_byte(int r, int c) { const int st = (r >> 4) * 2 + (c >> 5), rr = r & 15, cc = c & 31, ob = rr * 64 + cc * 2; return st * 1024 + (ob ^ (((ob >> 9) & 1) << 5)); }
__host__ __device__ __forceinline__ void stage_rc(int b, int& R, int& C) { const int st = b / 1024, sb = b % 1024, swz = sb ^ (((sb >> 9) & 1) << 5); R = (st >> 1) * 16 + swz / 64; C = (st & 1) * 32 + (swz % 64) / 2; }
__host__ __device__ __forceinline__ int perm32(int rho) { const int n = rho >> 4, i = rho & 15; return 8 * (i >> 2) + 4 * n + (i & 3); }

__device__ __forceinline__ unsigned cvt_pk_bf16(float lo, float hi) { unsigned r; asm volatile("v_cvt_pk_bf16_f32 %0, %1, %2" : "=v"(r) : "v"(lo), "v"(hi)); return r; }
struct Unit { int pm, pn; };
struct Gemm { const bf16_t* A; const bf16_t* Bt; int M, N, K; };

struct StaticOrder {
    int nM, nN, nwg, G, c;
    __host__ __device__ __forceinline__ void init(int M, int N, int G_, int c_) { nM = M / BM; nN = N / BM; nwg = nM * nN; G = G_; c = c_; }
    __host__ __device__ __forceinline__ bool next(int i, Unit& u) const {
        const long L = (long)i * G + c; if (L >= nwg) return false;
        int wgid = (int)L; { const int q = nwg / NXCD, r = nwg % NXCD, xcd = wgid % NXCD, off = wgid / NXCD; wgid = (xcd < r ? xcd * (q + 1) : r * (q + 1) + (xcd - r) * q) + off; }
        const int nig = WGM * nN, gid = wgid / nig, fm = gid * WGM, gsz = (nM - fm) < WGM ? (nM - fm) : WGM;
        u.pm = fm + ((wgid % nig) % gsz); u.pn = (wgid % nig) / gsz; return true;
    }
    __device__ __forceinline__ void a_ready(const Unit&) const {}
    __device__ __forceinline__ void done(const Unit&) const {}
};

struct EpiBf16 {
    static constexpr bool PERM = true, AFTER_DRAIN = false, NONTRANS = false;
    bf16_t* O; int ldc; int gelu_from;
    __device__ __forceinline__ void operator()(const f32x4 (&acc)[2][2][4][2], const Unit& u, int wr, int wc, int fr, int fq) const {
        const int row0 = u.pm * BM + wr * 64 + fr; const int col0 = u.pn * BM + wc * 32 + 8 * fq;
        const bool act = u.pn >= gelu_from;
#pragma unroll
        for (int ai = 0; ai < 2; ++ai)
#pragma unroll
            for (int m = 0; m < 4; ++m) { bf16_t* rowp = O + (size_t)(row0 + ai * HALF + m * 16) * ldc + col0;
#pragma unroll
                for (int bj = 0; bj < 2; ++bj) { f32x4 v0 = acc[ai][bj][m][0], v1 = acc[ai][bj][m][1];
                    if (act) {
#pragma unroll
                        for (int e = 0; e < 4; ++e) { v0[e] = gelu_tanh(v0[e]); v1[e] = gelu_tanh(v1[e]); } }
                    u32x4 w; w.x = cvt_pk_bf16(v0[0], v0[1]); w.y = cvt_pk_bf16(v0[2], v0[3]); w.z = cvt_pk_bf16(v1[0], v1[1]); w.w = cvt_pk_bf16(v1[2], v1[3]);
                    *(u32x4*)(rowp + bj * HALF) = w; } }
    }
};
struct EpiZ2 {
    static constexpr bool PERM = true, AFTER_DRAIN = false, NONTRANS = false;
    bf16_t* Zo; bf16_t* CQNo; bf16_t* CKVNo; bf16_t* KRo; const float* gq; const float* gkv; const float* rope; PG8_LAS float* P;
    __device__ __forceinline__ void operator()(const f32x4 (&acc)[2][2][4][2], const Unit& u, int wr, int wc, int fr, int fq) const {
        const int row0 = u.pm * BM + wr * 64 + fr;
        if (u.pn >= 2) {
            const int col0 = u.pn * BM + wc * 32 + 8 * fq;
#pragma unroll
            for (int ai = 0; ai < 2; ++ai)
#pragma unroll
                for (int m = 0; m < 4; ++m) { bf16_t* rowp = Zo + (size_t)(row0 + ai * HALF + m * 16) * NZ + col0;
#pragma unroll
                    for (int bj = 0; bj < 2; ++bj) { f32x4 v0 = acc[ai][bj][m][0], v1 = acc[ai][bj][m][1];
#pragma unroll
                        for (int e = 0; e < 4; ++e) { v0[e] = gelu_tanh(v0[e]); v1[e] = gelu_tanh(v1[e]); }
                        u32x4 w; w.x = cvt_pk_bf16(v0[0], v0[1]); w.y = cvt_pk_bf16(v0[2], v0[3]); w.z = cvt_pk_bf16(v1[0], v1[1]); w.w = cvt_pk_bf16(v1[2], v1[3]);
                        *(u32x4*)(rowp + bj * HALF) = w; } }
            return;
        }
        const bool isq = (u.pn == 0);
#pragma unroll
        for (int ai = 0; ai < 2; ++ai)
#pragma unroll
            for (int m = 0; m < 4; ++m) {
                const f32x4 a0 = acc[ai][0][m][0], a1 = acc[ai][0][m][1], b0 = acc[ai][1][m][0], b1 = acc[ai][1][m][1];
                float s = ((a0[0] * a0[0] + a0[1] * a0[1]) + (a0[2] * a0[2] + a0[3] * a0[3])) + ((a1[0] * a1[0] + a1[1] * a1[1]) + (a1[2] * a1[2] + a1[3] * a1[3]));
                if (isq) s += ((b0[0] * b0[0] + b0[1] * b0[1]) + (b0[2] * b0[2] + b0[3] * b0[3])) + ((b1[0] * b1[0] + b1[1] * b1[1]) + (b1[2] * b1[2] + b1[3] * b1[3]));
                s += __shfl_xor(s, 16); s += __shfl_xor(s, 32);
                if (fq == 0) P[(ai * HALF + wr * 64 + m * 16 + fr) * 4 + wc] = s;
            }
        asm volatile("s_waitcnt lgkmcnt(0)" ::: "memory"); __builtin_amdgcn_s_barrier(); asm volatile("" ::: "memory");
        const float invn = isq ? (1.0f / QL) : (1.0f / KVL);
        const int c8 = wc * 32 + 8 * fq;
        const float sgn = (fq < 2) ? -1.0f : 1.0f;
#pragma unroll
        for (int ai = 0; ai < 2; ++ai)
#pragma unroll
            for (int m = 0; m < 4; ++m) {
                const int rl = ai * HALF + wr * 64 + m * 16 + fr; const int row = u.pm * BM + rl;
                const float rs = rsqrtf(((P[rl * 4 + 0] + P[rl * 4 + 1]) + (P[rl * 4 + 2] + P[rl * 4 + 3])) * invn + EPS);
                if (isq) {
#pragma unroll
                    for (int bj = 0; bj < 2; ++bj) { const f32x4 g0 = *(const f32x4*)(gq + bj * HALF + c8), g1 = *(const f32x4*)(gq + bj * HALF + c8 + 4);
                        const f32x4 v0 = acc[ai][bj][m][0] * rs * g0, v1 = acc[ai][bj][m][1] * rs * g1;
                        u32x4 w; w.x = cvt_pk_bf16(v0[0], v0[1]); w.y = cvt_pk_bf16(v0[2], v0[3]); w.z = cvt_pk_bf16(v1[0], v1[1]); w.w = cvt_pk_bf16(v1[2], v1[3]);
                        *(u32x4*)(CQNo + (size_t)row * QL + bj * HALF + c8) = w; }
                } else {
                    { const f32x4 g0 = *(const f32x4*)(gkv + c8), g1 = *(const f32x4*)(gkv + c8 + 4);
                      const f32x4 v0 = acc[ai][0][m][0] * rs * g0, v1 = acc[ai][0][m][1] * rs * g1;
                      u32x4 w; w.x = cvt_pk_bf16(v0[0], v0[1]); w.y = cvt_pk_bf16(v0[2], v0[3]); w.z = cvt_pk_bf16(v1[0], v1[1]); w.w = cvt_pk_bf16(v1[2], v1[3]);
                      *(u32x4*)(CKVNo + (size_t)row * KVL + c8) = w; }
                    if (wc == 0) {
                        f32x4 v0 = acc[ai][1][m][0], v1 = acc[ai][1][m][1];
                        const float* rp = rope + (size_t)(row & (SEQ - 1)) * 32 + 16 * (fq & 1);
                        const f32x4 c0 = *(const f32x4*)rp, c1 = *(const f32x4*)(rp + 4), c2 = *(const f32x4*)(rp + 8), c3 = *(const f32x4*)(rp + 12);
                        const float cs[8] = {c0[0], c0[2], c1[0], c1[2], c2[0], c2[2], c3[0], c3[2]}, sn[8] = {c0[1], c0[3], c1[1], c1[3], c2[1], c2[3], c3[1], c3[3]};
#pragma unroll
                        for (int e = 0; e < 4; ++e) { const float o0 = __shfl_xor(v0[e], 32), o1 = __shfl_xor(v1[e], 32);
                            v0[e] = v0[e] * cs[e] + sgn * o0 * sn[e]; v1[e] = v1[e] * cs[4 + e] + sgn * o1 * sn[4 + e]; }
                        u32x4 w; w.x = cvt_pk_bf16(v0[0], v0[1]); w.y = cvt_pk_bf16(v0[2], v0[3]); w.z = cvt_pk_bf16(v1[0], v1[1]); w.w = cvt_pk_bf16(v1[2], v1[3]);
                        *(u32x4*)(KRo + (size_t)row * 32 + 8 * fq) = w;
                    }
                }
            }
    }
};
struct EpiQ {
    static constexpr bool PERM = true, AFTER_DRAIN = false, NONTRANS = false;
    bf16_t* O; const float* rope;
    __device__ __forceinline__ void operator()(const f32x4 (&acc)[2][2][4][2], const Unit& u, int wr, int wc, int fr, int fq) const {
        const int row0 = u.pm * BM + wr * 64 + fr; const int col0 = u.pn * BM + wc * 32 + 8 * fq;
        const float sgn = (fq < 2) ? -1.0f : 1.0f;
#pragma unroll
        for (int bj = 0; bj < 2; ++bj) {
            const int g32 = 8 * u.pn + 4 * bj + wc; const bool is_rope = (g32 % 3) == 2;
#pragma unroll
            for (int ai = 0; ai < 2; ++ai)
#pragma unroll
                for (int m = 0; m < 4; ++m) {
                    const int row = row0 + ai * HALF + m * 16;
                    f32x4 v0 = acc[ai][bj][m][0] * C2, v1 = acc[ai][bj][m][1] * C2;
                    if (is_rope) {
                        const float* rp = rope + (size_t)(row & (SEQ - 1)) * 32 + 16 * (fq & 1);
                        const f32x4 c0 = *(const f32x4*)rp, c1 = *(const f32x4*)(rp + 4), c2 = *(const f32x4*)(rp + 8), c3 = *(const f32x4*)(rp + 12);
                        const float cs[8] = {c0[0], c0[2], c1[0], c1[2], c2[0], c2[2], c3[0], c3[2]}, sn[8] = {c0[1], c0[3], c1[1], c1[3], c2[1], c2[3], c3[1], c3[3]};
#pragma unroll
                        for (int e = 0; e < 4; ++e) {
                            const float o0 = __shfl_xor(v0[e], 32), o1 = __shfl_xor(v1[e], 32);
                            v0[e] = v0[e] * cs[e] + sgn * o0 * sn[e]; v1[e] = v1[e] * cs[4 + e] + sgn * o1 * sn[4 + e];
                        }
                    }
                    u32x4 w; w.x = cvt_pk_bf16(v0[0], v0[1]); w.y = cvt_pk_bf16(v0[2], v0[3]); w.z = cvt_pk_bf16(v1[0], v1[1]); w.w = cvt_pk_bf16(v1[2], v1[3]);
                    *(u32x4*)(O + (size_t)row * NQ + col0 + bj * HALF) = w;
                }
        }
    }
};

struct EpiConv {
    static constexpr bool PERM = false, AFTER_DRAIN = false, NONTRANS = true;
    bf16_t* ACT; float* SIDE; const float* cw; const float* cb; PG8_LAS float* halo;
    __device__ __forceinline__ void operator()(const f32x4 (&acc)[2][2][4][2], const Unit& u, int wr, int wc, int fr, int fq) const {
        const int lane = threadIdx.x & 63;
        if (fq == 3) {
#pragma unroll
            for (int ai = 0; ai < 2; ++ai)
#pragma unroll
                for (int bj = 0; bj < 2; ++bj)
#pragma unroll
                    for (int n = 0; n < 2; ++n) { PG8_LAS float* hp = halo + (((((ai * 2 + wr) * 4 + wc) * 2 + bj) * 2 + n) * 32) + fr; hp[0] = acc[ai][bj][3][n][2]; hp[16] = acc[ai][bj][3][n][3]; }
        }
        asm volatile("s_waitcnt lgkmcnt(0)" ::: "memory"); __builtin_amdgcn_s_barrier(); asm volatile("" ::: "memory");
        const int j0 = 128 * u.pn + 32 * wc + 2 * fr;
        float wa[2][3], wb[2][3], ba[2], bb[2];
#pragma unroll
        for (int n = 0; n < 2; ++n) {
#pragma unroll
            for (int k = 0; k < 3; ++k) { wa[n][k] = cw[k * NUP + j0 + n]; wb[n][k] = cw[k * NUP + DFF + j0 + n]; }
            ba[n] = cb[j0 + n]; bb[n] = cb[DFF + j0 + n]; }
        const int src = ((lane - 16) & 63) * 4;
#pragma unroll
        for (int ai = 0; ai < 2; ++ai) {
            const int blk = 2 * ai + wr;
#pragma unroll
            for (int m = 0; m < 4; ++m) {
                float o[2][4];
#pragma unroll
                for (int n = 0; n < 2; ++n) {
                    const f32x4 Xa = acc[ai][0][m][n], Xb = acc[ai][1][m][n];
                    float da2, da3, db2, db3;
                    if (m > 0) { const bool t = (fq == 3); da2 = t ? acc[ai][0][m > 0 ? m - 1 : 0][n][2] : Xa[2]; da3 = t ? acc[ai][0][m > 0 ? m - 1 : 0][n][3] : Xa[3];
                                 db2 = t ? acc[ai][1][m > 0 ? m - 1 : 0][n][2] : Xb[2]; db3 = t ? acc[ai][1][m > 0 ? m - 1 : 0][n][3] : Xb[3]; }
                    else { da2 = Xa[2]; da3 = Xa[3]; db2 = Xb[2]; db3 = Xb[3]; }
                    float Ha2 = __builtin_bit_cast(float, __builtin_amdgcn_ds_bpermute(src, __builtin_bit_cast(int, da2)));
                    float Ha3 = __builtin_bit_cast(float, __builtin_amdgcn_ds_bpermute(src, __builtin_bit_cast(int, da3)));
                    float Hb2 = __builtin_bit_cast(float, __builtin_amdgcn_ds_bpermute(src, __builtin_bit_cast(int, db2)));
                    float Hb3 = __builtin_bit_cast(float, __builtin_amdgcn_ds_bpermute(src, __builtin_bit_cast(int, db3)));
                    if (m == 0) {
                        float h2a = 0.f, h3a = 0.f, h2b = 0.f, h3b = 0.f;
                        if (blk > 0) { const PG8_LAS float* hp = halo + ((((blk - 1) * 4 + wc) * 2 + 0) * 2 + n) * 32 + fr; h2a = hp[0]; h3a = hp[16]; h2b = hp[64]; h3b = hp[80]; }
                        if (fq == 0) { Ha2 = h2a; Ha3 = h3a; Hb2 = h2b; Hb3 = h3b; }
                    }
                    const f32x2_t W0 = {wa[n][0], wb[n][0]}, W1 = {wa[n][1], wb[n][1]}, W2 = {wa[n][2], wb[n][2]}, B2 = {ba[n], bb[n]};
                    const f32x2_t H2 = {Ha2, Hb2}, H3 = {Ha3, Hb3}, X0 = {Xa[0], Xb[0]}, X1 = {Xa[1], Xb[1]}, X2 = {Xa[2], Xb[2]}, X3 = {Xa[3], Xb[3]};
                    const f32x2_t y0 = B2 + W0 * H2 + W1 * H3 + W2 * X0, y1 = B2 + W0 * H3 + W1 * X0 + W2 * X1, y2 = B2 + W0 * X0 + W1 * X1 + W2 * X2, y3 = B2 + W0 * X1 + W1 * X2 + W2 * X3;
                    const float ya0 = y0[0], yb0 = y0[1], ya1 = y1[0], yb1 = y1[1], ya2 = y2[0], yb2 = y2[1], ya3 = y3[0], yb3 = y3[1];
                    o[n][0] = silu_f(ya0) * yb0; o[n][1] = silu_f(ya1) * yb1; o[n][2] = silu_f(ya2) * yb2; o[n][3] = silu_f(ya3) * yb3;
                    if (blk == 0 && m == 0 && fq == 0) { float* sp = SIDE + ((size_t)(u.pm * 4 + 0) * 2) * DFF + j0 + n; sp[0] = Xa[0]; sp[DFF] = Xb[0]; sp[2 * DFF] = Xa[1]; sp[3 * DFF] = Xb[1]; }
                    if (blk == 3 && m == 3 && fq == 3) { float* sp = SIDE + ((size_t)(u.pm * 4 + 2) * 2) * DFF + j0 + n; sp[0] = Xa[2]; sp[DFF] = Xb[2]; sp[2 * DFF] = Xa[3]; sp[3 * DFF] = Xb[3]; }
                }
                bf16_t* op = ACT + (size_t)(u.pm * BM + ai * HALF + wr * 64 + m * 16 + 4 * fq) * DFF + j0;
#pragma unroll
                for (int e = 0; e < 4; ++e) *(unsigned*)(op + (size_t)e * DFF) = cvt_pk_bf16(o[0][e], o[1][e]);
            }
        }
    }
};

struct PanelSS {
    float* xbuf; unsigned* cnt; int pm_off; float eps;
    __device__ __forceinline__ void run(const f32x4 (&v)[2][2][4][2], const Unit& u, int wr, int wc, int fr, int fq, PG8_LAS unsigned char* lds, int wid, int lane) const {
        PG8_LAS float* P = (PG8_LAS float*)lds; PG8_LAS float* S = (PG8_LAS float*)(lds + 4096);
        const int pmg = u.pm + pm_off;
#pragma unroll
        for (int ai = 0; ai < 2; ++ai)
#pragma unroll
            for (int m = 0; m < 4; ++m) {
                float s = 0.f;
#pragma unroll
                for (int bj = 0; bj < 2; ++bj)
#pragma unroll
                    for (int n = 0; n < 2; ++n) { const f32x4 x = v[ai][bj][m][n]; s += (x[0] * x[0] + x[1] * x[1]) + (x[2] * x[2] + x[3] * x[3]); }
                s += __shfl_xor(s, 16); s += __shfl_xor(s, 32);
                if (fq == 0) P[(ai * HALF + wr * 64 + m * 16 + fr) * 4 + wc] = s;
            }
        asm volatile("s_waitcnt lgkmcnt(0)" ::: "memory"); __builtin_amdgcn_s_barrier(); asm volatile("" ::: "memory");
        const int row = wid * 32 + (lane & 31);
        if (lane < 32) {
            const float tot = (P[row * 4 + 0] + P[row * 4 + 1]) + (P[row * 4 + 2] + P[row * 4 + 3]);
            __hip_atomic_store(xbuf + ((size_t)(pmg * BM + row) * 4 + u.pn), tot, __ATOMIC_RELAXED, __HIP_MEMORY_SCOPE_AGENT);
        }
        asm volatile("s_waitcnt vmcnt(0)" ::: "memory");
        if (lane == 0) __hip_atomic_fetch_add(cnt + 64 * pmg, 1u, __ATOMIC_RELAXED, __HIP_MEMORY_SCOPE_AGENT);
        if (wid == 0) {
            unsigned sp = 0;
            while ((unsigned)__builtin_amdgcn_readfirstlane(__hip_atomic_load(cnt + 64 * pmg, __ATOMIC_RELAXED, __HIP_MEMORY_SCOPE_AGENT)) < 32u) { __builtin_amdgcn_s_sleep(2); if (++sp > (1u << 22)) break; }
            __builtin_amdgcn_fence(__ATOMIC_ACQUIRE, "agent");
        }
        asm volatile("s_waitcnt vmcnt(0) lgkmcnt(0)" ::: "memory"); __builtin_amdgcn_s_barrier(); asm volatile("" ::: "memory");
        if (lane < 32) {
            const float* slot = xbuf + (size_t)(pmg * BM + row) * 4; float t = 0.f;
#pragma unroll
            for (int k = 0; k < 4; ++k) t += __hip_atomic_load(slot + k, __ATOMIC_RELAXED, __HIP_MEMORY_SCOPE_AGENT);
            S[row] = rsqrtf(t * (1.0f / 1024.0f) + eps);
        }
        asm volatile("s_waitcnt lgkmcnt(0)" ::: "memory"); __builtin_amdgcn_s_barrier(); asm volatile("" ::: "memory");
    }
};
struct EpiRmsRes {
    static constexpr bool PERM = false, AFTER_DRAIN = true, NONTRANS = false;
    const float* base; float* out; const float* gv; int row_off; PanelSS st;
    __device__ __forceinline__ void fused(f32x4 (&acc)[2][2][4][2], const Unit& u, int wr, int wc, int fr, int fq, PG8_LAS unsigned char* lds, int wid, int lane) const {
        const PG8_LAS float* S = (const PG8_LAS float*)(lds + 4096);
        const int col0 = u.pn * BM + wc * 32 + 4 * fq;
        st.run(acc, u, wr, wc, fr, fq, lds, wid, lane);
        f32x4 g[2][2];
#pragma unroll
        for (int bj = 0; bj < 2; ++bj)
#pragma unroll
            for (int n = 0; n < 2; ++n) g[bj][n] = *(const f32x4*)(gv + col0 + bj * HALF + n * 16);
#pragma unroll
        for (int ai = 0; ai < 2; ++ai)
#pragma unroll
            for (int m = 0; m < 4; ++m) { const int r = ai * HALF + wr * 64 + m * 16 + fr; const float rs = S[r]; const size_t off = (size_t)(row_off + u.pm * BM + r) * DM + col0;
#pragma unroll
                for (int bj = 0; bj < 2; ++bj)
#pragma unroll
                    for (int n = 0; n < 2; ++n) { const f32x4 bs = *(const f32x4*)(base + off + bj * HALF + n * 16); __builtin_nontemporal_store(bs + acc[ai][bj][m][n] * rs * g[bj][n], (f32x4*)(out + off + bj * HALF + n * 16)); }
                if (m & 1) asm volatile("" ::: "memory"); }
        asm volatile("s_waitcnt lgkmcnt(0)" ::: "memory"); __builtin_amdgcn_s_barrier(); asm volatile("" ::: "memory");
    }
};

struct EpiRmsResRms {
    static constexpr bool PERM = false, AFTER_DRAIN = true, NONTRANS = false;
    const float* base; float* out; bf16_t* xn; const float* gv1; const float* gv2; const float* sv2; int row_off; PanelSS st1, st2;
    __device__ __forceinline__ void fused(f32x4 (&acc)[2][2][4][2], const Unit& u, int wr, int wc, int fr, int fq, PG8_LAS unsigned char* lds, int wid, int lane) const {
        const PG8_LAS float* S = (const PG8_LAS float*)(lds + 4096);
        const int col0 = u.pn * BM + wc * 32 + 4 * fq;
        st1.run(acc, u, wr, wc, fr, fq, lds, wid, lane);
        {
            f32x4 g[2][2];
#pragma unroll
            for (int bj = 0; bj < 2; ++bj)
#pragma unroll
                for (int n = 0; n < 2; ++n) g[bj][n] = *(const f32x4*)(gv1 + col0 + bj * HALF + n * 16);
#pragma unroll
            for (int ai = 0; ai < 2; ++ai)
#pragma unroll
                for (int m = 0; m < 4; ++m) { const int r = ai * HALF + wr * 64 + m * 16 + fr; const float rs = S[r]; const size_t off = (size_t)(row_off + u.pm * BM + r) * DM + col0;
#pragma unroll
                    for (int bj = 0; bj < 2; ++bj)
#pragma unroll
                        for (int n = 0; n < 2; ++n) { const f32x4 bs = __builtin_nontemporal_load((const f32x4*)(base + off + bj * HALF + n * 16)); acc[ai][bj][m][n] = bs + acc[ai][bj][m][n] * rs * g[bj][n]; }
                    asm volatile("" : "+v"(acc[ai][0][m][0]), "+v"(acc[ai][0][m][1]), "+v"(acc[ai][1][m][0]), "+v"(acc[ai][1][m][1]));
                    if (m & 1) asm volatile("" ::: "memory"); }
        }
        st2.run(acc, u, wr, wc, fr, fq, lds, wid, lane);
        {
            f32x4 g[2][2], sv[2][2];
#pragma unroll
            for (int bj = 0; bj < 2; ++bj)
#pragma unroll
                for (int n = 0; n < 2; ++n) { g[bj][n] = *(const f32x4*)(gv2 + col0 + bj * HALF + n * 16); sv[bj][n] = *(const f32x4*)(sv2 + col0 + bj * HALF + n * 16); }
#pragma unroll
            for (int ai = 0; ai < 2; ++ai)
#pragma unroll
                for (int m = 0; m < 4; ++m) { const int r = ai * HALF + wr * 64 + m * 16 + fr; const float rs = S[r]; const size_t off = (size_t)(row_off + u.pm * BM + r) * DM + col0;
#pragma unroll
                    for (int bj = 0; bj < 2; ++bj)
#pragma unroll
                        for (int n = 0; n < 2; ++n) { const f32x4 x1 = acc[ai][bj][m][n]; *(f32x4*)(out + off + bj * HALF + n * 16) = x1;
                            const f32x4 o = x1 * rs * g[bj][n] + sv[bj][n]; u32x2 w; w.x = cvt_pk_bf16(o[0], o[1]); w.y = cvt_pk_bf16(o[2], o[3]); *(u32x2*)(xn + off + bj * HALF + n * 16) = w; }
                    asm volatile("" ::: "memory"); }
        }
        asm volatile("s_waitcnt lgkmcnt(0)" ::: "memory"); __builtin_amdgcn_s_barrier(); asm volatile("" ::: "memory");
    }
};

template <class Epi, class Sched, bool ALIGN_EPI = false, bool SP2 = false>
__device__ __forceinline__ void gemm_phase(PG8_LAS unsigned char* lds, const Gemm g, const Sched& S, const Epi& E) {
    int tid_ = threadIdx.x; asm volatile("" : "+v"(tid_));
    const int tid = tid_, wid = __builtin_amdgcn_readfirstlane(tid >> 6), lane = tid & 63, wr = wid >> 2, wc = wid & 3, fr = lane & 15, fq = lane >> 4;
    const int K = g.K, nt = K / BK;
    unsigned voffA[2], voffB[2];
#pragma unroll
    for (int i = 0; i < 2; ++i) { int R, C; stage_rc(tid * 16 + i * 8192, R, C); const int Rb = Epi::PERM ? ((R & ~31) + perm32(R & 31)) : R;
        voffA[i] = (unsigned)(R * K + C) * 2u; voffB[i] = (unsigned)(Rb * K + C) * 2u; }
    const size_t kstep = (size_t)(BK * 2);
    const size_t hstep = (size_t)HALF * K * 2;
    const size_t tstep = 2 * hstep;
    const unsigned ldsw = (unsigned)wid * 1024u;
    const int aoff = lds_byte(wr * 64 + fr, fq * 8), boff = lds_byte(wc * 32 + fr, fq * 8);
#define PG8_SA(b, h) (((b) * 2 + (h)) * HTB)
#define PG8_SB(b, h) ((4 + (b) * 2 + (h)) * HTB)
#define PG8_STAGE(bufoff, gbase, voff) do { _Pragma("unroll") for (int _i = 0; _i < 2; ++_i) \
        __builtin_amdgcn_global_load_lds((const unsigned*)((const char*)(gbase) + (voff)[_i]), (PG8_LAS unsigned*)(lds + (bufoff) + ldsw + _i * 8192), 16, 0, 0); } while (0)
#define PG8_LDA(dst, b, h) do { _Pragma("unroll") for (int m = 0; m < 4; ++m) _Pragma("unroll") for (int k = 0; k < 2; ++k) dst[m][k] = *(const PG8_LAS bf16x8*)(lds + PG8_SA(b, h) + aoff + m * 2048 + k * 1024); } while (0)
#define PG8_LDB(dst, b, h) do { _Pragma("unroll") for (int n = 0; n < 2; ++n) _Pragma("unroll") for (int k = 0; k < 2; ++k) dst[n][k] = *(const PG8_LAS bf16x8*)(lds + PG8_SB(b, h) + boff + n * 2048 + k * 1024); } while (0)
#define PG8_MMA(ai, bj, At, Bt) do { __builtin_amdgcn_s_setprio(1); _Pragma("unroll") for (int m = 0; m < 4; ++m) _Pragma("unroll") for (int n = 0; n < 2; ++n) _Pragma("unroll") for (int k = 0; k < 2; ++k) \
        acc[ai][bj][m][n] = Epi::NONTRANS ? __builtin_amdgcn_mfma_f32_16x16x32_bf16(At[m][k], Bt[n][k], acc[ai][bj][m][n], 0, 0, 0) : __builtin_amdgcn_mfma_f32_16x16x32_bf16(Bt[n][k], At[m][k], acc[ai][bj][m][n], 0, 0, 0); __builtin_amdgcn_s_setprio(0); } while (0)
#define PG8_WAIT_V(n) asm volatile("s_waitcnt vmcnt(" #n ")" ::: "memory")
#define PG8_WAIT_L(n) asm volatile("s_waitcnt lgkmcnt(" #n ")" ::: "memory")
#define PG8_BAR __builtin_amdgcn_s_barrier()
#define PG8_SCHED __builtin_amdgcn_sched_barrier(0)
    Unit cur, nxt; int ui = 0;
    if (!S.next(0, cur)) return;
    f32x4 acc[2][2][4][2];
#pragma unroll
    for (int a = 0; a < 2; ++a)
#pragma unroll
        for (int b = 0; b < 2; ++b)
#pragma unroll
            for (int m = 0; m < 4; ++m)
#pragma unroll
                for (int n = 0; n < 2; ++n) acc[a][b][m][n] = (f32x4){0.f, 0.f, 0.f, 0.f};
    bf16x8 At[4][2], B0[2][2], B1[2][2];
    const char* cA = (const char*)g.A + (size_t)cur.pm * tstep; const char* cB = (const char*)g.Bt + (size_t)cur.pn * tstep;
    S.a_ready(cur);
    if constexpr (SP2) {
        PG8_STAGE(PG8_SB(0, 0), cB, voffB); PG8_STAGE(PG8_SB(0, 1), cB + hstep, voffB); PG8_STAGE(PG8_SA(0, 0), cA, voffA); PG8_STAGE(PG8_SA(0, 1), cA + hstep, voffA);
        if (wr == 1) PG8_BAR;
        PG8_WAIT_V(2); PG8_BAR;
        PG8_STAGE(PG8_SB(1, 0), cB + kstep, voffB); PG8_STAGE(PG8_SA(1, 0), cA + kstep, voffA); PG8_STAGE(PG8_SB(1, 1), cB + hstep + kstep, voffB);
        PG8_WAIT_V(6); PG8_BAR;
    } else {
        PG8_STAGE(PG8_SB(0, 0), cB, voffB); PG8_STAGE(PG8_SA(0, 0), cA, voffA); PG8_STAGE(PG8_SB(0, 1), cB + hstep, voffB); PG8_STAGE(PG8_SA(0, 1), cA + hstep, voffA);
        if (wr == 1) PG8_BAR;
        PG8_WAIT_V(4); PG8_BAR;
        PG8_STAGE(PG8_SB(1, 0), cB + kstep, voffB); PG8_STAGE(PG8_SA(1, 0), cA + kstep, voffA); PG8_STAGE(PG8_SB(1, 1), cB + hstep + kstep, voffB);
        PG8_WAIT_V(6); PG8_BAR;
    }
    for (;;) {
        const bool has_next = S.next(ui + 1, nxt);
        const char* nA = has_next ? (const char*)g.A + (size_t)nxt.pm * tstep : cA; const char* nB = has_next ? (const char*)g.Bt + (size_t)nxt.pn * tstep : cB;
        for (int t = 0; t < nt; t += 2) {
            const bool last = (t == nt - 2);
            const char* a1 = cA + (size_t)(t + 1) * kstep;
            const char* a2 = last ? nA : cA + (size_t)(t + 2) * kstep; const char* b2 = last ? nB : cB + (size_t)(t + 2) * kstep;
            const char* a3 = a2 + kstep; const char* b3 = b2 + kstep;
            if (last && has_next) S.a_ready(nxt);
            if constexpr (SP2) {
            PG8_LDB(B0, 0, 0); PG8_LDB(B1, 0, 1); PG8_SCHED; PG8_LDA(At, 0, 0); PG8_STAGE(PG8_SA(1, 1), a1 + hstep, voffA);
            PG8_WAIT_V(8); PG8_WAIT_L(0); PG8_BAR; PG8_MMA(0, 0, At, B0); PG8_MMA(0, 1, At, B1); PG8_BAR; PG8_SCHED;
            PG8_LDA(At, 0, 1); PG8_STAGE(PG8_SB(0, 0), b2, voffB); PG8_STAGE(PG8_SB(0, 1), b2 + hstep, voffB); PG8_STAGE(PG8_SA(0, 0), a2, voffA);
            PG8_WAIT_V(8); PG8_WAIT_L(0); PG8_BAR; PG8_MMA(1, 0, At, B0); PG8_MMA(1, 1, At, B1); PG8_BAR; PG8_SCHED;
            PG8_LDB(B0, 1, 0); PG8_LDB(B1, 1, 1); PG8_SCHED; PG8_LDA(At, 1, 0); PG8_STAGE(PG8_SA(0, 1), a2 + hstep, voffA);
            PG8_WAIT_V(8); PG8_WAIT_L(0); PG8_BAR; PG8_MMA(0, 0, At, B0); PG8_MMA(0, 1, At, B1); PG8_BAR; PG8_SCHED;
            PG8_LDA(At, 1, 1); PG8_STAGE(PG8_SB(1, 0), b3, voffB); PG8_STAGE(PG8_SB(1, 1), b3 + hstep, voffB); PG8_STAGE(PG8_SA(1, 0), a3, voffA);
            PG8_WAIT_V(8); PG8_WAIT_L(0); PG8_BAR; PG8_MMA(1, 0, At, B0); PG8_MMA(1, 1, At, B1); PG8_BAR; PG8_SCHED;
            } else {
            PG8_LDB(B0, 0, 0); PG8_SCHED; PG8_LDA(At, 0, 0); PG8_STAGE(PG8_SA(1, 1), a1 + hstep, voffA);
            PG8_WAIT_L(8); PG8_BAR; PG8_WAIT_L(0); PG8_MMA(0, 0, At, B0); PG8_BAR; PG8_SCHED;
            PG8_LDB(B1, 0, 1); PG8_STAGE(PG8_SB(0, 0), b2, voffB);
            PG8_BAR; PG8_WAIT_L(0); PG8_MMA(0, 1, At, B1); PG8_BAR;
            PG8_LDA(At, 0, 1); PG8_STAGE(PG8_SA(0, 0), a2, voffA);
            PG8_BAR; PG8_WAIT_L(0); PG8_MMA(1, 0, At, B0); PG8_BAR; PG8_SCHED;
            PG8_STAGE(PG8_SB(0, 1), b2 + hstep, voffB);
            PG8_WAIT_V(6); PG8_BAR; PG8_MMA(1, 1, At, B1); PG8_BAR;
            PG8_LDB(B0, 1, 0); PG8_SCHED; PG8_LDA(At, 1, 0); PG8_STAGE(PG8_SA(0, 1), a2 + hstep, voffA);
            PG8_WAIT_L(8); PG8_BAR; PG8_WAIT_L(0); PG8_MMA(0, 0, At, B0); PG8_BAR; PG8_SCHED;
            PG8_LDB(B1, 1, 1); PG8_STAGE(PG8_SB(1, 0), b3, voffB);
            PG8_BAR; PG8_WAIT_L(0); PG8_MMA(0, 1, At, B1); PG8_BAR;
            PG8_LDA(At, 1, 1); PG8_STAGE(PG8_SA(1, 0), a3, voffA);
            PG8_BAR; PG8_WAIT_L(0); PG8_MMA(1, 0, At, B0); PG8_BAR; PG8_SCHED;
            PG8_STAGE(PG8_SB(1, 1), b3 + hstep, voffB);
            PG8_WAIT_V(6); PG8_BAR; PG8_MMA(1, 1, At, B1); PG8_BAR;
            }
        }
        if constexpr (ALIGN_EPI) { if (wr == 0) PG8_BAR; }
        if constexpr (!Epi::AFTER_DRAIN) { E(acc, cur, wr, wc, fr, fq); S.done(cur); }
        if (!has_next) break;
#pragma unroll
        for (int a = 0; a < 2; ++a)
#pragma unroll
            for (int b = 0; b < 2; ++b)
#pragma unroll
                for (int m = 0; m < 4; ++m)
#pragma unroll
                    for (int n = 0; n < 2; ++n) acc[a][b][m][n] = (f32x4){0.f, 0.f, 0.f, 0.f};
        cur = nxt; cA = nA; cB = nB; ++ui;
        if constexpr (ALIGN_EPI) { if (wr == 1) PG8_BAR; }
    }
    PG8_WAIT_V(0);
    if constexpr (!ALIGN_EPI) { if (wr == 0) PG8_BAR; }
    PG8_BAR;
    if constexpr (Epi::AFTER_DRAIN) { E.fused(acc, cur, wr, wc, fr, fq, lds, wid, lane); S.done(cur); }
#undef PG8_SA
#undef PG8_SB
#undef PG8_STAGE
#undef PG8_LDA
#undef PG8_LDB
#undef PG8_MMA
#undef PG8_WAIT_V
#undef PG8_WAIT_L
#undef PG8_BAR
#undef PG8_SCHED
}
}
#define XB_TMO      128
#define XB_XCNT(j)  (256  + 64 * (j))
#define XB_XSUB(j)  (1280 + 64 * (j))
#define XB_XGEN(j)  (2304 + 64 * (j))
#define XB_TOP      3328
#define XB_TOPGEN   3392
#define XCD_BAR_WORDS 3456
#define XB_SPIN_CAP (1u << 18)

__device__ __forceinline__ unsigned xb_ld(unsigned* p)              { return __hip_atomic_load(p, __ATOMIC_RELAXED, __HIP_MEMORY_SCOPE_AGENT); }
__device__ __forceinline__ unsigned xb_add(unsigned* p, unsigned v) { return __hip_atomic_fetch_add(p, v, __ATOMIC_RELAXED, __HIP_MEMORY_SCOPE_AGENT); }
__device__ __forceinline__ unsigned xb_xcc_id() { return (unsigned)__builtin_amdgcn_s_getreg((3 << 11) | 20) & 0xFu; }
#define XB_SPIN(cond, bar) do { unsigned _sp = 0; while (cond) { __builtin_amdgcn_s_sleep(1); \
    if ((++_sp & 255u) == 0u) { if (xb_ld(&(bar)[XB_TMO])) break; if (_sp > XB_SPIN_CAP) { atomicAdd(&(bar)[XB_TMO], 1u); break; } } } } while (0)

struct XcdBarrier {
    unsigned* bar; unsigned x;
    volatile LAS unsigned* st;
};

__device__ __forceinline__ XcdBarrier xcd_barrier_post(unsigned* bar, volatile LAS unsigned* st) {
    XcdBarrier b; b.bar = bar; b.x = xb_xcc_id(); b.st = st;
    if (threadIdx.x == 0) (void)xb_add(&bar[XB_XCNT(b.x)], 1u);
    return b;
}
__device__ __forceinline__ void xcd_barrier_complete(unsigned* bar, unsigned x, unsigned& nloc, unsigned& nx) {
    const unsigned G = gridDim.x * gridDim.y * gridDim.z;
    unsigned sum, cnt, mine, sp = 0u;
    for (;;) {
        sum = 0u; cnt = 0u; mine = 0u;
#pragma unroll 1
        for (unsigned j = 0; j < 16; ++j) { const unsigned c = xb_ld(&bar[XB_XCNT(j)]); sum += c; cnt += (c > 0u) ? 1u : 0u; mine = (j == x) ? c : mine; }
        if (sum == G) break;
        __builtin_amdgcn_s_sleep(1);
        if ((++sp & 255u) == 0u) { if (xb_ld(&bar[XB_TMO])) break; if (sp > XB_SPIN_CAP) { atomicAdd(&bar[XB_TMO], 1u); break; } }
    }
    nloc = mine > 0u ? mine : 1u; nx = cnt > 0u ? cnt : 1u;
}

__device__ __forceinline__ void xcd_barrier(const XcdBarrier& b) {
    asm volatile("s_waitcnt vmcnt(0)" ::: "memory");
    __syncthreads();
    if (threadIdx.x == 0) {
        unsigned* bar = b.bar;
        __builtin_amdgcn_s_waitcnt(0);
        unsigned nloc = b.st[0], nx = b.st[1];
        if (nloc == 0u) { xcd_barrier_complete(bar, b.x, nloc, nx); b.st[0] = nloc; b.st[1] = nx; }
        const unsigned old = xb_add(&bar[XB_XSUB(b.x)], 1u);
        const unsigned gen = old / nloc;
        if (old + 1u == (gen + 1u) * nloc) {
            __builtin_amdgcn_fence(__ATOMIC_RELEASE, "agent");
            asm volatile("s_waitcnt vmcnt(0)" ::: "memory");
            const unsigned og = xb_add(&bar[XB_TOP], 1u);
            const unsigned tg = og / nx;
            if (og + 1u == (tg + 1u) * nx) xb_add(&bar[XB_TOPGEN], 1u);
            else XB_SPIN(xb_ld(&bar[XB_TOPGEN]) == tg, bar);
            __builtin_amdgcn_fence(__ATOMIC_ACQUIRE, "agent");
            xb_add(&bar[XB_XGEN(b.x)], 1u);
            asm volatile("s_waitcnt vmcnt(0)" ::: "memory");
        } else {
            XB_SPIN(xb_ld(&bar[XB_XGEN(b.x)]) == gen, bar);
            __builtin_amdgcn_fence(__ATOMIC_ACQUIRE, "agent");
            asm volatile("s_waitcnt vmcnt(0)" ::: "memory");
        }
    }
    __syncthreads();
}

__device__ __forceinline__ void tr_item(const float* __restrict__ W, int K, int N, bf16_t* WT, int k0, int n0, int drow0, LAS float* scr, int lane, bool perm = false) {
#pragma unroll 8
    for (int i = 0; i < 32; ++i) { const int kk = 2 * i + (lane >> 5); scr[kk * 33 + (lane & 31)] = W[(size_t)(k0 + kk) * N + n0 + (lane & 31)]; }
    asm volatile("s_waitcnt lgkmcnt(0)" ::: "memory");
    const int c = lane & 7;
#pragma unroll
    for (int j = 0; j < 4; ++j) { const int n = (lane >> 3) + 8 * j; const LAS float* s = scr + (8 * c) * 33 + n;
        u32x4 o; o.x = pk2(s[0 * 33], s[1 * 33]); o.y = pk2(s[2 * 33], s[3 * 33]); o.z = pk2(s[4 * 33], s[5 * 33]); o.w = pk2(s[6 * 33], s[7 * 33]);
        *(u32x4*)(WT + (size_t)(drow0 + (perm ? 16 * (n & 1) + (n >> 1) : n)) * K + k0 + 8 * c) = o; }
    asm volatile("s_waitcnt lgkmcnt(0)" ::: "memory");
}

typedef float f32x2v __attribute__((ext_vector_type(2)));
__device__ __forceinline__ float max3f(float a, float b, float c) { return fmaxf(fmaxf(a, b), c); }
__device__ __forceinline__ void attn_ldk(bf16x8 (&kf)[12], const LAS unsigned char* kb) {
    constexpr int KP = 104;
#pragma unroll
    for (int ks = 0; ks < 6; ++ks) { kf[2 * ks] = *(const LAS bf16x8*)(kb + 32 * ks); kf[2 * ks + 1] = *(const LAS bf16x8*)(kb + 32 * KP * 2 + 32 * ks); }
}
__device__ __forceinline__ void attn_ldv(bf16x8 (&vf)[8], const LAS unsigned char* vb) {
    constexpr int VP = 136;
#pragma unroll
    for (int s = 0; s < 4; ++s) { vf[2 * s] = *(const LAS bf16x8*)(vb + 32 * s); vf[2 * s + 1] = *(const LAS bf16x8*)(vb + 32 * VP * 2 + 32 * s); }
}
__device__ __forceinline__ void attn_qk(f32x16& p0, f32x16& p1, const bf16x8 (&kf)[12], const bf16x8 (&qf)[6]) {
    const f32x16 zero = {0.f, 0.f, 0.f, 0.f, 0.f, 0.f, 0.f, 0.f, 0.f, 0.f, 0.f, 0.f, 0.f, 0.f, 0.f, 0.f};
#pragma unroll
    for (int ks = 0; ks < 6; ++ks) {
        p0 = __builtin_amdgcn_mfma_f32_32x32x16_bf16(kf[2 * ks], qf[ks], ks == 0 ? zero : p0, 0, 0, 0);
        p1 = __builtin_amdgcn_mfma_f32_32x32x16_bf16(kf[2 * ks + 1], qf[ks], ks == 0 ? zero : p1, 0, 0, 0);
    }
}
__device__ __forceinline__ void attn_softmax(f32x16& p0, f32x16& p1, bf16x8 (&pb)[4], f32x16& o0, f32x16& o1, float& m_run, float& l_run) {
    float mx = max3f(p0[0], p0[1], p1[0]), my = max3f(p0[2], p0[3], p1[1]);
    mx = max3f(mx, p1[2], p1[3]);
#pragma unroll
    for (int r = 4; r < 16; r += 4) { mx = max3f(mx, p0[r], p0[r + 1]); my = max3f(my, p0[r + 2], p0[r + 3]); mx = max3f(mx, p1[r], p1[r + 1]); my = max3f(my, p1[r + 2], p1[r + 3]); }
    mx = fmaxf(mx, my);
    { auto rr = __builtin_amdgcn_permlane32_swap(__float_as_uint(mx), __float_as_uint(mx), false, false); mx = fmaxf(__uint_as_float(rr[0]), __uint_as_float(rr[1])); }
    const float m_new = fmaxf(m_run, mx);
    const float alpha = __builtin_amdgcn_exp2f(m_run - m_new);
    m_run = m_new;
    p0 = p0 - m_new; p1 = p1 - m_new;
#pragma unroll
    for (int r = 0; r < 16; ++r) { p0[r] = __builtin_amdgcn_exp2f(p0[r]); p1[r] = __builtin_amdgcn_exp2f(p1[r]); }
    f32x16 sm = p0 + p1;
    f32x2v s2 = (f32x2v){sm[0], sm[1]} + (f32x2v){sm[2], sm[3]};
#pragma unroll
    for (int r = 4; r < 16; r += 2) s2 += (f32x2v){sm[r], sm[r + 1]};
    l_run = l_run * alpha + (s2[0] + s2[1]);
    o0 = o0 * alpha; o1 = o1 * alpha;
#pragma unroll
    for (int s = 0; s < 2; ++s) {
        u32x4 w; w.x = pk2(p0[8 * s], p0[8 * s + 1]); w.y = pk2(p0[8 * s + 2], p0[8 * s + 3]); w.z = pk2(p0[8 * s + 4], p0[8 * s + 5]); w.w = pk2(p0[8 * s + 6], p0[8 * s + 7]);
        pb[s] = __builtin_bit_cast(bf16x8, w);
        u32x4 w2; w2.x = pk2(p1[8 * s], p1[8 * s + 1]); w2.y = pk2(p1[8 * s + 2], p1[8 * s + 3]); w2.z = pk2(p1[8 * s + 4], p1[8 * s + 5]); w2.w = pk2(p1[8 * s + 6], p1[8 * s + 7]);
        pb[2 + s] = __builtin_bit_cast(bf16x8, w2);
    }
}
__device__ __forceinline__ void attn_pv(const bf16x8 (&vf)[8], const bf16x8 (&pb)[4], f32x16& o0, f32x16& o1) {
#pragma unroll
    for (int s = 0; s < 4; ++s) {
        o0 = __builtin_amdgcn_mfma_f32_32x32x16_bf16(vf[2 * s], pb[s], o0, 0, 0, 0);
        o1 = __builtin_amdgcn_mfma_f32_32x32x16_bf16(vf[2 * s + 1], pb[s], o1, 0, 0, 0);
    }
}
__device__ __forceinline__ void attn_phase(LAS unsigned char* lds, const bf16_t* __restrict__ Q, const bf16_t* __restrict__ KN, const bf16_t* __restrict__ KR,
                                           const bf16_t* __restrict__ VT, bf16_t* AO, int vcu, int G, int tid, int lane, int wave) {
    constexpr int KP = 104, VP = 136, KBUF = 128 * KP * 2, VBUF = 64 * VP * 2, BUF = KBUF + VBUF;
    if (wave >= 4) __builtin_amdgcn_s_setprio(1);
    const int r32 = lane & 31, hi = lane >> 5;
    const int pr = (r32 & ~12) | ((r32 & 4) << 1) | ((r32 & 8) >> 1);
    const int key_l = tid >> 3, kc = tid & 7, key_r = tid >> 2, rc = tid & 3, vd = tid >> 3, vc = tid & 7;
    for (int p = vcu; p < 512; p += G) {
#pragma unroll 1
        for (int half = 0; half < 2; ++half) {
            const int bh = p >> 3, pp = p & 7, qb = half ? 15 - pp : pp, b = bh >> 3, h = bh & 7;
            const size_t rowbase = (size_t)b * SEQ;
            const int qrow0 = qb * 256 + wave * 32, qc = qrow0 >> 6, NT2 = 2 * qb + 2;
            bf16x8 qf[6];
            { const bf16_t* qp = Q + (rowbase + qrow0 + r32) * NQ + h * 96 + 8 * hi;
#pragma unroll
              for (int ks = 0; ks < 6; ++ks) qf[ks] = *(const bf16x8*)(qp + 16 * ks); }
            const char* kbase = (const char*)(KN + rowbase * NKN + h * 64); const unsigned koff = (unsigned)(key_l * NKN + 8 * kc) * 2u;
            const char* rbase = (const char*)(KR + rowbase * 32); const unsigned roff = (unsigned)(key_r * 32 + 8 * rc) * 2u;
            const char* vbase = (const char*)(VT + (size_t)(h * 64) * MTOK + rowbase); const unsigned voff = (unsigned)((size_t)vd * MTOK + 8 * vc) * 2u;
            const int kdst = (key_l * KP + 8 * kc) * 2, rdst = (key_r * KP + 64 + 8 * rc) * 2, vdst = KBUF + (vd * VP + 8 * vc) * 2;
            u32x4 gk0, gk1, gr, gv0, gv1;
            gk0 = *(const u32x4*)(kbase + koff); gk1 = *(const u32x4*)(kbase + 64 * NKN * 2 + koff); gr = *(const u32x4*)(rbase + roff); gv0 = *(const u32x4*)(vbase + voff); gv1 = *(const u32x4*)(vbase + 128 + voff);
            *(LAS u32x4*)(lds + kdst) = gk0; *(LAS u32x4*)(lds + kdst + 64 * KP * 2) = gk1; *(LAS u32x4*)(lds + rdst) = gr; *(LAS u32x4*)(lds + vdst) = gv0; *(LAS u32x4*)(lds + vdst + 128) = gv1;
            __syncthreads();
            float m_run = -INFINITY, l_run = 0.f;
            f32x16 o0, o1;
#pragma unroll
            for (int r = 0; r < 16; ++r) { o0[r] = 0.f; o1[r] = 0.f; }
#define PREFETCH_NEXT() do { if (more) { const size_t ko = (size_t)(t + 1) * 128;                     const char* kb2 = kbase + ko * NKN * 2; const char* rb2 = rbase + ko * 64; const char* vb2 = vbase + ko * 2;                     gk0 = *(const u32x4*)(kb2 + koff); gk1 = *(const u32x4*)(kb2 + 64 * NKN * 2 + koff); gr = *(const u32x4*)(rb2 + roff); gv0 = *(const u32x4*)(vb2 + voff); gv1 = *(const u32x4*)(vb2 + 128 + voff); } } while (0)
            for (int t = 0; t < NT2; ++t) {
                const bool more = (t + 1 < NT2);
                const LAS unsigned char* buf = lds + (t & 1) * BUF;
                const LAS unsigned char* kA = buf + (pr * KP + 8 * hi) * 2; const LAS unsigned char* vA = buf + KBUF + (r32 * VP + 8 * hi) * 2;
                if (2 * t + 1 <= qc) {
                    bf16x8 kf[12], kf2[12], vf[8], vf2[8], pa[4], pb2[4]; f32x16 a0, a1, b0, b1;
                    attn_ldk(kf, kA);
                    __builtin_amdgcn_sched_barrier(0);
                    attn_qk(a0, a1, kf, qf);
                    attn_ldk(kf2, kA + 64 * KP * 2);
                    __builtin_amdgcn_sched_barrier(0);
                    attn_qk(b0, b1, kf2, qf);
                    attn_softmax(a0, a1, pa, o0, o1, m_run, l_run);
                    attn_ldv(vf, vA);
                    __builtin_amdgcn_sched_barrier(0);
                    PREFETCH_NEXT();
                    attn_ldv(vf2, vA + 128);
                    __builtin_amdgcn_sched_barrier(0);
                    attn_pv(vf, pa, o0, o1);
                    attn_softmax(b0, b1, pb2, o0, o1, m_run, l_run);
                    __builtin_amdgcn_sched_barrier(0);
                    attn_pv(vf2, pb2, o0, o1);
                } else if (2 * t <= qc) {
                    bf16x8 kf[12], vf[8], pa[4]; f32x16 a0, a1;
                    PREFETCH_NEXT();
                    attn_ldk(kf, kA);
                    __builtin_amdgcn_sched_barrier(0);
                    attn_qk(a0, a1, kf, qf);
                    __builtin_amdgcn_sched_barrier(0);
                    attn_ldv(vf, vA);
                    __builtin_amdgcn_sched_barrier(0);
                    attn_softmax(a0, a1, pa, o0, o1, m_run, l_run);
                    __builtin_amdgcn_sched_barrier(0);
                    attn_pv(vf, pa, o0, o1);
                } else { PREFETCH_NEXT(); }
                if (more) { LAS unsigned char* nb = lds + ((t + 1) & 1) * BUF;
                    *(LAS u32x4*)(nb + kdst) = gk0; *(LAS u32x4*)(nb + kdst + 64 * KP * 2) = gk1; *(LAS u32x4*)(nb + rdst) = gr; *(LAS u32x4*)(nb + vdst) = gv0; *(LAS u32x4*)(nb + vdst + 128) = gv1; }
                __syncthreads();
            }
            const float l = l_run + __shfl_xor(l_run, 32);
            const float inv = 1.0f / l;
            bf16_t* op = AO + (rowbase + qrow0 + r32) * DM + h * 64 + 4 * hi;
#pragma unroll
            for (int g = 0; g < 4; ++g) {
                u32x2 w; w.x = pk2(o0[4 * g] * inv, o0[4 * g + 1] * inv); w.y = pk2(o0[4 * g + 2] * inv, o0[4 * g + 3] * inv);
                *(u32x2*)(op + 8 * g) = w;
                u32x2 w2; w2.x = pk2(o1[4 * g] * inv, o1[4 * g + 1] * inv); w2.y = pk2(o1[4 * g + 2] * inv, o1[4 * g + 3] * inv);
                *(u32x2*)(op + 32 + 8 * g) = w2;
            }
        }
    }
    __builtin_amdgcn_s_setprio(0);
}

#undef PREFETCH_NEXT
__global__ void __launch_bounds__(512, 2) mega_fwd(Args a) {
    extern __shared__ __attribute__((aligned(16))) unsigned char lds_raw[];
    LAS unsigned char* lds = (LAS unsigned char*)lds_raw;
    cg::grid_group grid = cg::this_grid();
    if (threadIdx.x < 16) ((LAS unsigned*)(lds + 131072))[threadIdx.x] = 0u;
    __syncthreads();
    XcdBarrier xbar; { KARGS(); xbar = xcd_barrier_post((unsigned*)(KA->ws + WS_BAR), (volatile LAS unsigned*)(lds + 131072)); }
#define tid (otid())
#define lane (otid() & 63)
#define wave (__builtin_amdgcn_readfirstlane((int)(threadIdx.x >> 6)))
#define G ((int)gridDim.x)
#define bx ((int)blockIdx.x)
#define vcu ((G % 8 == 0) ? (bx % 8) * (G / 8) + bx / 8 : bx)
#define gw (vcu * 8 + wave)
#define NGW (G * 8)
#define gid (bx * 512 + tid)
#define NT_ALL (G * 512)
#define ws (KA->ws)
#define ADA ((float*)(ws + WS_ADA))
#define ROPE ((float*)(ws + WS_ROPE))
#define WSP ((bf16_t*)(ws + WS_WSP))
#define WIN ((bf16_t*)(ws + WS_WIN))
#define WUQ ((bf16_t*)(ws + WS_WUQ))
#define WUK ((bf16_t*)(ws + WS_WUK))
#define WUV ((bf16_t*)(ws + WS_WUV))
#define WO ((bf16_t*)(ws + WS_WO))
#define WUP ((bf16_t*)(ws + WS_WUP))
#define WDN ((bf16_t*)(ws + WS_WDN))
#define XN ((bf16_t*)(ws + WS_XN))
#define Z ((bf16_t*)(ws + WS_Z))
#define CQN ((bf16_t*)(ws + WS_CQN))
#define CKVN ((bf16_t*)(ws + WS_CKVN))
#define KR ((bf16_t*)(ws + WS_KR))
#define Q ((bf16_t*)(ws + WS_Q))
#define KN ((bf16_t*)(ws + WS_KN))
#define VT ((bf16_t*)(ws + WS_VT))
#define AO ((bf16_t*)(ws + WS_AO))
#define MB ((bf16_t*)(ws + WS_MB))
#define SIDE ((float*)(ws + WS_SIDE))
#define ACT ((bf16_t*)(ws + WS_ACT))
#define FB ((bf16_t*)(ws + WS_FB))
    { KARGS();
    {
        LAS float* cact = (LAS float*)lds;
        for (int i = tid; i < NB * DM; i += 512) cact[i] = silu_f(KA->c[i]);
        __syncthreads();
        for (int it = gw; it < 768; it += NGW) {
            const int cb = it % 24, kc = it / 24, n0 = cb * 256 + lane * 4, k0 = kc * 32;
            f32x4 acc[8];
#pragma unroll
            for (int b = 0; b < 8; ++b) acc[b] = (f32x4){0.f, 0.f, 0.f, 0.f};
#pragma unroll 8
            for (int kk = 0; kk < 32; ++kk) {
                const f32x4 w = *(const f32x4*)(KA->w_ada + (size_t)(k0 + kk) * 6144 + n0);
#pragma unroll
                for (int b = 0; b < 8; ++b) acc[b] += cact[b * DM + k0 + kk] * w;
            }
            if (kc == 0) { const f32x4 bv = *(const f32x4*)(KA->b_ada + n0);
#pragma unroll
                for (int b = 0; b < 8; ++b) acc[b] += bv; }
#pragma unroll
            for (int b = 0; b < 8; ++b)
#pragma unroll
                for (int e = 0; e < 4; ++e) __hip_atomic_fetch_add(ADA + b * 6144 + n0 + e, acc[b][e], __ATOMIC_RELAXED, __HIP_MEMORY_SCOPE_AGENT);
        }
        __syncthreads();
        LAS float* scr = (LAS float*)(lds + wave * 16384);
#pragma unroll 1
        for (int rep0_ = 0; rep0_ < (PROBE == 12 ? 2 : 1); ++rep0_) {
        constexpr int I_IN = 16 * 45, I_UQ = 4 * 24, I_UKV = 2 * 32, I_O = 16 * 32, I_UP = 16 * 176, I_DN = 44 * 32;
        constexpr int NITEMS = I_IN + I_UQ + I_UKV + I_O + I_UP + I_DN;
        for (int it = (gw + NGW - (768 % NGW)) % NGW; it < NITEMS; it += NGW) {
            int r = it;
            if (r < I_IN) { const int kb = r / 45, n0 = 32 * (r % 45); tr_item(KA->w_in, DM, 1440, WIN, 64 * kb, n0, n0 + (n0 >= 416 ? 96 : 0), scr, lane); continue; } r -= I_IN;
            if (r < I_UQ) { const int kb = r / 24, n0 = 32 * (r % 24); tr_item(KA->w_uq, QL, NQ, WUQ, 64 * kb, n0, n0, scr, lane); continue; } r -= I_UQ;
            if (r < I_UKV) { const int kb = r / 32, n0 = 32 * (r % 32); const int hh = n0 >> 7, q4 = (n0 & 127) >> 5;
                tr_item(KA->w_ukv, KVL, 1024, q4 < 2 ? WUK : WUV, 64 * kb, n0, hh * 64 + 32 * (q4 & 1), scr, lane); continue; } r -= I_UKV;
            if (r < I_O) { const int kb = r / 32, n0 = 32 * (r % 32); tr_item(KA->w_out, DM, DM, WO, 64 * kb, n0, n0, scr, lane); continue; } r -= I_O;
            if (r < I_UP) { const int kb = r / 176, n0 = 32 * (r % 176); const int isb = n0 >= DFF, j = isb ? n0 - DFF : n0;
                tr_item(KA->w_up, DM, NUP, WUP, 64 * kb, n0, 256 * (j >> 7) + 128 * isb + (j & 127), scr, lane, true); continue; } r -= I_UP;
            { const int kb = r / 32, n0 = 32 * (r % 32); tr_item(KA->w_down, DFF, DM, WDN, 64 * kb, n0, n0, scr, lane); }
        }
        for (int i = gid; i < 96 * 1024 / 8; i += NT_ALL) *(u32x4*)(WIN + (size_t)416 * 1024 + (size_t)i * 8) = (u32x4){0u, 0u, 0u, 0u};
        for (int i = gid; i < 8 * 128 * 128; i += NT_ALL) { const int ii = (i >> 7) & 127, jj = i & 127; const float v = ((jj >> 6) <= (ii >> 6)) ? KA->w_spatial[i] : 0.f; WSP[i] = (bf16_t)(pk2(v, 0.f) & 0xffffu); }
        for (int i = gid; i < SEQ * 16; i += NT_ALL) { const int s = i >> 4, f = i & 15;
            const float inv = exp2f(-(float)f * (13.287712379549449f / 16.0f));
            const float ang = (float)s * inv;
            const double rev = (double)ang * 0.15915494309189535; const float fr = (float)(rev - floor(rev));
            ROPE[2 * i] = __builtin_amdgcn_cosf(fr); ROPE[2 * i + 1] = __builtin_amdgcn_sinf(fr); }
        }
    }
    }
    { KARGS(); if (KA->out == nullptr) grid.sync(); }
    GSYNC();

    { KARGS();
    for (int idx = gid; idx < NB * DM; idx += NT_ALL) { const int b = idx >> 10, c = idx & 1023; const float* ad = ADA + b * 6144; float* gvp = (float*)(ws + WS_GV);
        gvp[idx] = KA->g_post_mix[c] * ad[2048 + c]; gvp[8192 + idx] = KA->g_pre_ffn[c] * (1.0f + ad[4096 + c]); gvp[16384 + idx] = ad[3072 + c]; gvp[24576 + idx] = KA->g_post_ffn[c] * ad[5120 + c]; }

#pragma unroll 1
    for (int rep_ = 0; rep_ < (PROBE == 7 ? 2 : 1); ++rep_) {
    for (int r0 = gw * 16; r0 < MTOK; r0 += NGW * 16) {
        const int b = r0 >> 12; const float* ad = ADA + b * 6144;
        f32x4 A1[4], B1[4];
#pragma unroll
        for (int j = 0; j < 4; ++j) { const int c = 4 * lane + 256 * j; const f32x4 g = *(const f32x4*)(KA->g_pre_mix + c), sc = *(const f32x4*)(ad + 1024 + c); A1[j] = g * (1.0f + sc); B1[j] = *(const f32x4*)(ad + c); }
        f32x4 vn[4];
#pragma unroll
        for (int j = 0; j < 4; ++j) vn[j] = __builtin_nontemporal_load((const f32x4*)(KA->x + (size_t)r0 * DM + 4 * lane + 256 * j));
        for (int rr = 0; rr < 16; ++rr) {
            const size_t row = (size_t)(r0 + rr), nrow = (size_t)(r0 + (rr < 15 ? rr + 1 : 15));
            f32x4 v[4]; float ss = 0.f;
#pragma unroll
            for (int j = 0; j < 4; ++j) { v[j] = vn[j]; vn[j] = __builtin_nontemporal_load((const f32x4*)(KA->x + nrow * DM + 4 * lane + 256 * j)); ss += (v[j][0] * v[j][0] + v[j][1] * v[j][1]) + (v[j][2] * v[j][2] + v[j][3] * v[j][3]); }
            const float rs = rsqrtf(wave_sum(ss) * (1.0f / DM) + EPS);
#pragma unroll
            for (int j = 0; j < 4; ++j) { const f32x4 o = v[j] * rs * A1[j] + B1[j]; u32x2 w; w.x = pk2(o[0], o[1]); w.y = pk2(o[2], o[3]); *(u32x2*)(XN + row * DM + 4 * lane + 256 * j) = w; }
        }
    }
    }
    }
    GSYNC();

    { KARGS();
#pragma unroll 1
    for (int rep_ = 0; rep_ < (PROBE == 10 ? 2 : 1); ++rep_) {
    { pg8::Gemm g{XN, WIN, MTOK, NZ, DM}; pg8::StaticOrder S; S.init(MTOK, NZ, G, bx); pg8::EpiZ2 E{Z, CQN, CKVN, KR, KA->g_q, KA->g_kv, ROPE, (LAS float*)(lds + 131072 + 1024)};
      pg8::gemm_phase<pg8::EpiZ2, pg8::StaticOrder, true, true>(lds, g, S, E); }
    }
    }
    GSYNC();

    { KARGS();
#pragma unroll 1
    for (int rep_ = 0; rep_ < (PROBE == 3 ? 2 : 1); ++rep_) {
    {
        constexpr int VLP = 136;
        LAS bf16_t* VLT = (LAS bf16_t*)lds;
        const int r32 = lane & 31, hi = lane >> 5, iblk = wave >> 1, dblk = wave & 1;
        const int jt = tid >> 2, qd = tid & 3;
        u32x4 r0, r1; f32x4 lgv[4], lbv[4];
        const int ustep = (G == 256) ? 1 : G;
        const int jx = vcu & 31;
        const int u0 = (G == 256) ? (256 * (vcu >> 5) + (jx < 16 ? 7 * jx : 112 + 9 * (jx - 16))) : vcu;
        const int ucnt = (G == 256) ? (bx < 128 ? 7 : 9) : (vcu < 2048 ? (2047 - vcu) / G + 1 : 0);
        if (ucnt > 0) { const bf16_t* vp = Z + ((size_t)(u0 >> 3) * 128 + jt) * NZ + 1024 + (u0 & 7) * 64 + 16 * qd; r0 = *(const u32x4*)vp; r1 = *(const u32x4*)(vp + 8);
#pragma unroll
            for (int e4 = 0; e4 < 4; ++e4) { lgv[e4] = *(const f32x4*)(KA->gm_ln_g + (u0 & 7) * 64 + 16 * qd + 4 * e4); lbv[e4] = *(const f32x4*)(KA->gm_ln_b + (u0 & 7) * 64 + 16 * qd + 4 * e4); } }
        for (int ui = 0, u = u0; ui < ucnt; ++ui, u += ustep) {
            const int blk = u >> 3, h = u & 7; const size_t t0 = (size_t)blk * 128;
            {
                float xv[16];
                xv[0] = bf_lo(r0.x); xv[1] = bf_hi(r0.x); xv[2] = bf_lo(r0.y); xv[3] = bf_hi(r0.y); xv[4] = bf_lo(r0.z); xv[5] = bf_hi(r0.z); xv[6] = bf_lo(r0.w); xv[7] = bf_hi(r0.w);
                xv[8] = bf_lo(r1.x); xv[9] = bf_hi(r1.x); xv[10] = bf_lo(r1.y); xv[11] = bf_hi(r1.y); xv[12] = bf_lo(r1.z); xv[13] = bf_hi(r1.z); xv[14] = bf_lo(r1.w); xv[15] = bf_hi(r1.w);
                float sm = 0.f;
#pragma unroll
                for (int e = 0; e < 16; ++e) sm += xv[e];
                sm += __shfl_xor(sm, 1); sm += __shfl_xor(sm, 2);
                const float mu = sm * (1.0f / 64.0f); float q = 0.f;
#pragma unroll
                for (int e = 0; e < 16; ++e) { xv[e] -= mu; q += xv[e] * xv[e]; }
                q += __shfl_xor(q, 1); q += __shfl_xor(q, 2);
                const float rstd = rsqrtf(q * (1.0f / 64.0f) + EPS);
#pragma unroll
                for (int e = 0; e < 16; ++e) { const float y = xv[e] * rstd * lgv[e >> 2][e & 3] + lbv[e >> 2][e & 3]; VLT[(16 * qd + e) * VLP + jt] = (bf16_t)(pk2(y, 0.f) & 0xffffu); }
            }
            const int un = u + ustep;
            if (ui + 1 < ucnt) { const bf16_t* vp = Z + ((size_t)(un >> 3) * 128 + jt) * NZ + 1024 + (un & 7) * 64 + 16 * qd; r0 = *(const u32x4*)vp; r1 = *(const u32x4*)(vp + 8);
#pragma unroll
                for (int e4 = 0; e4 < 4; ++e4) { lgv[e4] = *(const f32x4*)(KA->gm_ln_g + (un & 7) * 64 + 16 * qd + 4 * e4); lbv[e4] = *(const f32x4*)(KA->gm_ln_b + (un & 7) * 64 + 16 * qd + 4 * e4); } }
            const int itok = 32 * iblk + r32;
            const bf16_t* up = Z + (t0 + itok) * NZ + 512 + h * 64 + 32 * dblk + 4 * hi;
            u32x2 uu[4];
#pragma unroll
            for (int g = 0; g < 4; ++g) uu[g] = *(const u32x2*)(up + 8 * g);
            const float bsp = KA->b_spatial[h * 128 + itok];
            bf16x8 wf[8];
            { const bf16_t* wp = WSP + ((size_t)h * 128 + itok) * 128 + 8 * hi;
#pragma unroll
              for (int s = 0; s < 8; ++s) if (s < 4 || iblk >= 2) wf[s] = *(const bf16x8*)(wp + 16 * s); }
            __syncthreads();
            {
                f32x16 acc;
#pragma unroll
                for (int r = 0; r < 16; ++r) acc[r] = 0.f;
                const LAS bf16_t* vl = VLT + (32 * dblk + r32) * VLP + 8 * hi;
#pragma unroll
                for (int s = 0; s < 8; ++s) if (s < 4 || iblk >= 2) {
                    const bf16x8 vf = *(const LAS bf16x8*)(vl + 16 * s);
                    acc = __builtin_amdgcn_mfma_f32_32x32x16_bf16(vf, wf[s], acc, 0, 0, 0);
                }
                bf16_t* op = AO + (t0 + itok) * DM + 512 + h * 64 + 32 * dblk + 4 * hi;
#pragma unroll
                for (int g = 0; g < 4; ++g) {
                    u32x2 w; w.x = pk2(bf_lo(uu[g].x) * (acc[4 * g] + bsp), bf_hi(uu[g].x) * (acc[4 * g + 1] + bsp)); w.y = pk2(bf_lo(uu[g].y) * (acc[4 * g + 2] + bsp), bf_hi(uu[g].y) * (acc[4 * g + 3] + bsp));
                    *(u32x2*)(op + 8 * g) = w;
                }
            }
            __syncthreads();
        }
    }
    }
    }

    { KARGS();
#pragma unroll 1
    for (int rep_ = 0; rep_ < (PROBE == 4 ? 2 : 1); ++rep_) {
    { int Kh = QL; asm volatile("" : "+s"(Kh)); pg8::Gemm g{CQN, WUQ, MTOK, NQ, Kh}; pg8::StaticOrder S; S.init(MTOK, NQ, G, bx); pg8::EpiQ E{Q, ROPE};
      pg8::gemm_phase<pg8::EpiQ, pg8::StaticOrder, true, true>(lds, g, S, E); }
    }
    { KARGS();
    { int Kh = KVL; asm volatile("" : "+s"(Kh)); pg8::Gemm g{CKVN, WUK, MTOK, NKN, Kh}; pg8::StaticOrder S; S.init(MTOK, NKN, G, bx); pg8::EpiBf16 E{KN, NKN, 1 << 30};
      pg8::gemm_phase<pg8::EpiBf16, pg8::StaticOrder, true, true>(lds, g, S, E); }
    }
    { KARGS();
    { int Kh = KVL; asm volatile("" : "+s"(Kh)); pg8::Gemm g{WUV, CKVN, 512, MTOK, Kh}; pg8::StaticOrder S; S.init(512, MTOK, G, bx); pg8::EpiBf16 E{VT, MTOK, 1 << 30};
      pg8::gemm_phase<pg8::EpiBf16, pg8::StaticOrder, true, true>(lds, g, S, E); }
    }
    }
    GSYNC();

    { KARGS();
    attn_phase(lds, Q, KN, KR, VT, AO, vcu, G, tid, lane, wave);
#if PROBE == 2
    __syncthreads();
    attn_phase(lds, Q, KN, KR, VT, AO, vcu, G, tid, lane, wave);
#endif
    }
    GSYNC();

    if (G == 256) {
#pragma unroll 1
        for (int call = 0; call < 2; ++call) { KARGS();
            pg8::Gemm g{AO + (size_t)call * (MTOK / 2) * DM, WO, MTOK / 2, DM, DM}; pg8::StaticOrder S; S.init(MTOK / 2, DM, G, bx);
            pg8::PanelSS st1{(float*)(ws + WS_XB) + 1 * 131072, (unsigned*)(ws + WS_CNT) + 1 * 8192, 64 * call, EPS};
            pg8::PanelSS st2{(float*)(ws + WS_XB) + 2 * 131072, (unsigned*)(ws + WS_CNT) + 2 * 8192, 64 * call, EPS};
            pg8::Unit u0; u0.pm = 0; u0.pn = 0; (void)S.next(0, u0);
            const float* gvb = (const float*)(ws + WS_GV) + (call * 4 + (u0.pm >> 4)) * DM;
            pg8::EpiRmsResRms E2{KA->x, KA->out, XN, gvb, gvb + 8192, gvb + 16384, call * (MTOK / 2), st1, st2};
            pg8::gemm_phase<pg8::EpiRmsResRms, pg8::StaticOrder, false, true>(lds, g, S, E2); }
        GSYNC();
    } else {
    { KARGS();
#pragma unroll 1
    for (int rep_ = 0; rep_ < (PROBE == 8 ? 2 : 1); ++rep_) {
    { pg8::Gemm g{AO, WO, MTOK, DM, DM}; pg8::StaticOrder S; S.init(MTOK, DM, G, bx); pg8::EpiBf16 E{MB, DM, 1 << 30};
      pg8::gemm_phase<pg8::EpiBf16, pg8::StaticOrder, true, true>(lds, g, S, E); }
    }
    }
    GSYNC();

    { KARGS();
#pragma unroll 1
    for (int rep_ = 0; rep_ < (PROBE == 6 ? 2 : 1); ++rep_) {
    for (int r0 = gw * 16; r0 < MTOK; r0 += NGW * 16) {
        const int b = r0 >> 12; const float* ad = ADA + b * 6144;
        f32x4 G1[4], G2[4], S2[4];
#pragma unroll
        for (int j = 0; j < 4; ++j) { const int c = 4 * lane + 256 * j;
            G1[j] = *(const f32x4*)(KA->g_post_mix + c) * *(const f32x4*)(ad + 2048 + c);
            G2[j] = *(const f32x4*)(KA->g_pre_ffn + c) * (1.0f + *(const f32x4*)(ad + 4096 + c));
            S2[j] = *(const f32x4*)(ad + 3072 + c); }
        u32x2 mn[4]; f32x4 xn[4];
#pragma unroll
        for (int j = 0; j < 4; ++j) { mn[j] = *(const u32x2*)(MB + (size_t)r0 * DM + 4 * lane + 256 * j); xn[j] = *(const f32x4*)(KA->x + (size_t)r0 * DM + 4 * lane + 256 * j); }
        for (int rr = 0; rr < 16; ++rr) {
            const size_t row = (size_t)(r0 + rr), nrow = (size_t)(r0 + (rr < 15 ? rr + 1 : 15));
            f32x4 mv[4], xv[4]; float ss = 0.f;
#pragma unroll
            for (int j = 0; j < 4; ++j) { const u32x2 w = mn[j]; mv[j] = (f32x4){bf_lo(w.x), bf_hi(w.x), bf_lo(w.y), bf_hi(w.y)}; xv[j] = xn[j];
                mn[j] = *(const u32x2*)(MB + nrow * DM + 4 * lane + 256 * j); xn[j] = *(const f32x4*)(KA->x + nrow * DM + 4 * lane + 256 * j);
                ss += (mv[j][0] * mv[j][0] + mv[j][1] * mv[j][1]) + (mv[j][2] * mv[j][2] + mv[j][3] * mv[j][3]); }
            const float rs = rsqrtf(wave_sum(ss) * (1.0f / DM) + EPS);
            float s2 = 0.f;
#pragma unroll
            for (int j = 0; j < 4; ++j) { xv[j] = xv[j] + mv[j] * rs * G1[j]; *(f32x4*)(KA->out + row * DM + 4 * lane + 256 * j) = xv[j];
                s2 += (xv[j][0] * xv[j][0] + xv[j][1] * xv[j][1]) + (xv[j][2] * xv[j][2] + xv[j][3] * xv[j][3]); }
            const float r2 = rsqrtf(wave_sum(s2) * (1.0f / DM) + EPS);
#pragma unroll
            for (int j = 0; j < 4; ++j) { const f32x4 o = xv[j] * r2 * G2[j] + S2[j]; u32x2 w; w.x = pk2(o[0], o[1]); w.y = pk2(o[2], o[3]); *(u32x2*)(XN + row * DM + 4 * lane + 256 * j) = w; }
        }
    }
    }
    }
    GSYNC();
    }

    { KARGS();
#pragma unroll 1
    for (int rep_ = 0; rep_ < (PROBE == 9 ? 2 : 1); ++rep_) {
    { pg8::Gemm g{XN, WUP, MTOK, NUP, DM}; pg8::StaticOrder S; S.init(MTOK, NUP, G, bx); pg8::EpiConv E{ACT, SIDE, KA->conv_w, KA->conv_b, (LAS float*)(lds + 131072 + 1024)};
      pg8::gemm_phase<pg8::EpiConv, pg8::StaticOrder, true, true>(lds, g, S, E); }
    }
    }
    GSYNC();

    { KARGS();
    for (int idx = gid; idx < 128 * DFF; idx += NT_ALL) {
        const int pm = idx / DFF, j = idx - pm * DFF;
        if ((pm & 15) == 0) continue;
        const float* sp = SIDE + ((size_t)((pm - 1) * 4 + 2) * 2) * DFF + j;
        const float* sc = SIDE + ((size_t)(pm * 4 + 0) * 2) * DFF + j;
        const float p2a = sp[0], p2b = sp[DFF], p1a = sp[2 * DFF], p1b = sp[3 * DFF], x0a = sc[0], x0b = sc[DFF], x1a = sc[2 * DFF], x1b = sc[3 * DFF];
        const float wa0 = KA->conv_w[j], wa1 = KA->conv_w[NUP + j], wa2 = KA->conv_w[2 * NUP + j], wb0 = KA->conv_w[DFF + j], wb1 = KA->conv_w[NUP + DFF + j], wb2 = KA->conv_w[2 * NUP + DFF + j];
        const float ba = KA->conv_b[j], bb = KA->conv_b[DFF + j];
        const float ya0 = ba + wa0 * p2a + wa1 * p1a + wa2 * x0a, ya1 = ba + wa0 * p1a + wa1 * x0a + wa2 * x1a;
        const float yb0 = bb + wb0 * p2b + wb1 * p1b + wb2 * x0b, yb1 = bb + wb0 * p1b + wb1 * x0b + wb2 * x1b;
        ACT[(size_t)(pm * 256) * DFF + j] = (bf16_t)(pk2(silu_f(ya0) * yb0, 0.f) & 0xffffu);
        ACT[(size_t)(pm * 256 + 1) * DFF + j] = (bf16_t)(pk2(silu_f(ya1) * yb1, 0.f) & 0xffffu);
    }
    }
    GSYNC();

    if (G == 256) {
#pragma unroll 1
        for (int call = 0; call < 2; ++call) { KARGS();
            pg8::Gemm g{ACT + (size_t)call * (MTOK / 2) * DFF, WDN, MTOK / 2, DM, DFF}; pg8::StaticOrder S; S.init(MTOK / 2, DM, G, bx);
            pg8::PanelSS st{(float*)(ws + WS_XB), (unsigned*)(ws + WS_CNT), 64 * call, EPS};
            pg8::Unit u0; u0.pm = 0; u0.pn = 0; (void)S.next(0, u0);
            pg8::EpiRmsRes E2{KA->out, KA->out, (const float*)(ws + WS_GV) + 24576 + (call * 4 + (u0.pm >> 4)) * DM, call * (MTOK / 2), st};
            pg8::gemm_phase<pg8::EpiRmsRes, pg8::StaticOrder, false, true>(lds, g, S, E2); }
    } else {
    { KARGS();
#pragma unroll 1
    for (int rep_ = 0; rep_ < (PROBE == 11 ? 2 : 1); ++rep_) {
    { pg8::Gemm g{ACT, WDN, MTOK, DM, DFF}; pg8::StaticOrder S; S.init(MTOK, DM, G, bx); pg8::EpiBf16 E{FB, DM, 1 << 30};
      pg8::gemm_phase<pg8::EpiBf16, pg8::StaticOrder, true, true>(lds, g, S, E); }
    }
    }
    GSYNC();

    { KARGS();
    for (int r0 = gw * 16; r0 < MTOK; r0 += NGW * 16) {
        const int b = r0 >> 12; const float* ad = ADA + b * 6144;
        f32x4 G3[4];
#pragma unroll
        for (int j = 0; j < 4; ++j) { const int c = 4 * lane + 256 * j; G3[j] = *(const f32x4*)(KA->g_post_ffn + c) * *(const f32x4*)(ad + 5120 + c); }
        u32x2 fn[4]; f32x4 xn[4];
#pragma unroll
        for (int j = 0; j < 4; ++j) { fn[j] = *(const u32x2*)(FB + (size_t)r0 * DM + 4 * lane + 256 * j); xn[j] = *(const f32x4*)(KA->out + (size_t)r0 * DM + 4 * lane + 256 * j); }
        for (int rr = 0; rr < 16; ++rr) {
            const size_t row = (size_t)(r0 + rr); const bool last = (rr == 15); const size_t nrow = (size_t)(r0 + (last ? 15 : rr + 1));
            f32x4 fv[4], x1[4]; float ss = 0.f;
#pragma unroll
            for (int j = 0; j < 4; ++j) { const u32x2 w = fn[j]; fv[j] = (f32x4){bf_lo(w.x), bf_hi(w.x), bf_lo(w.y), bf_hi(w.y)}; x1[j] = xn[j];
                if (!last) { fn[j] = *(const u32x2*)(FB + nrow * DM + 4 * lane + 256 * j); xn[j] = *(const f32x4*)(KA->out + nrow * DM + 4 * lane + 256 * j); }
                ss += (fv[j][0] * fv[j][0] + fv[j][1] * fv[j][1]) + (fv[j][2] * fv[j][2] + fv[j][3] * fv[j][3]); }
            const float rs = rsqrtf(wave_sum(ss) * (1.0f / DM) + EPS);
#pragma unroll
            for (int j = 0; j < 4; ++j) *(f32x4*)(KA->out + row * DM + 4 * lane + 256 * j) = x1[j] + fv[j] * rs * G3[j];
        }
    }
    }
    }
}

#undef tid
#undef lane
#undef wave
#undef G
#undef bx
#undef vcu
#undef gw
#undef NGW
#undef gid
#undef NT_ALL
#undef ws
#undef ADA
#undef ROPE
#undef WSP
#undef WIN
#undef WUQ
#undef WUK
#undef WUV
#undef WO
#undef WUP
#undef WDN
#undef XN
#undef Z
#undef CQN
#undef CKVN
#undef KR
#undef Q
#undef KN
#undef VT
#undef AO
#undef MB
#undef SIDE
#undef ACT
#undef FB
extern "C" void kernel_launch(void* const* d_in, const int* in_sizes, int n_in, void* d_out, int out_size, void* d_ws, size_t ws_size, hipStream_t stream) {
    static int grid = 0;
    if (grid == 0) {
        if (n_in != 22 || ws_size < WS_END) { fprintf(stderr, "kernel_launch: unexpected inputs (n_in %d, ws %zu)\n", n_in, ws_size); grid = -1; return; }
        int dev = 0, cus = 0, per_cu = 0;
        (void)hipGetDevice(&dev); (void)hipDeviceGetAttribute(&cus, hipDeviceAttributeMultiprocessorCount, dev);
        (void)hipFuncSetAttribute((const void*)mega_fwd, hipFuncAttributeMaxDynamicSharedMemorySize, LDS_BYTES);
        if (hipOccupancyMaxActiveBlocksPerMultiprocessor(&per_cu, (const void*)mega_fwd, 512, LDS_BYTES) != hipSuccess || per_cu < 1) per_cu = 1;
        (void)hipGetLastError();
        grid = cus * per_cu; if (grid <= 0) grid = 256;
    }
    if (grid < 0) return;
    (void)hipMemsetAsync((char*)d_ws + WS_ADA, 0, CTL_ZERO_BYTES, stream);
    Args a{};
    const float** ap = (const float**)&a;
    for (int i = 0; i < 22; ++i) ap[i] = (const float*)d_in[i];
    a.out = (float*)d_out; a.ws = (unsigned char*)d_ws;
    void* args[] = {&a};
    hipError_t e = hipLaunchCooperativeKernel((const void*)mega_fwd, dim3(grid), dim3(512), args, LDS_BYTES, stream);
    if (e != hipSuccess) fprintf(stderr, "cooperative launch failed: %s (grid %d)\n", hipGetErrorString(e), grid);
}
```

```cpp
#define PROBE 0
#include <hip/hip_runtime.h>
#include <hip/hip_cooperative_groups.h>
#include <cstdio>
#include <cstdint>
namespace cg = cooperative_groups;
#ifndef PROBE
#define PROBE 0
#endif
#if PROBE == 1
#define GSYNC() do { xcd_barrier(xbar); xcd_barrier(xbar); } while (0)
#else
#define GSYNC() xcd_barrier(xbar)
#endif

#define LAS __attribute__((address_space(3)))
typedef unsigned short bf16_t;
typedef short bf16x8 __attribute__((ext_vector_type(8)));
typedef float f32x4 __attribute__((ext_vector_type(4)));
typedef float f32x16 __attribute__((ext_vector_type(16)));
typedef unsigned u32x4 __attribute__((ext_vector_type(4)));
typedef unsigned u32x2 __attribute__((ext_vector_type(2)));
typedef float f32x2_t __attribute__((ext_vector_type(2)));
typedef __bf16 bf16x2_t __attribute__((ext_vector_type(2)));

__device__ __forceinline__ unsigned pk2(float lo, float hi) { f32x2_t v = {lo, hi}; bf16x2_t b = __builtin_convertvector(v, bf16x2_t); return __builtin_bit_cast(unsigned, b); }
__device__ __forceinline__ float bf_lo(unsigned u) { return __uint_as_float(u << 16); }
__device__ __forceinline__ float bf_hi(unsigned u) { return __uint_as_float(u & 0xffff0000u); }
__device__ __forceinline__ float wave_sum(float v) {
#pragma unroll
    for (int o = 1; o < 64; o <<= 1) v += __shfl_xor(v, o);
    return v;
}
__device__ __forceinline__ float gelu_tanh(float x) {
    const float t = x * (1.0f + 0.044715f * x * x);
    const float e = __builtin_amdgcn_exp2f(-2.0f * 0.7978845608028654f * 1.4426950408889634f * t);
    return x * __builtin_amdgcn_rcpf(1.0f + e);
}
__device__ __forceinline__ float silu_f(float x) { return x * __builtin_amdgcn_rcpf(1.0f + __builtin_amdgcn_exp2f(-1.4426950408889634f * x)); }

constexpr int NB = 8, SEQ = 4096, DM = 1024, MTOK = NB * SEQ;
constexpr int NZ = 1536;
constexpr int QL = 256, KVL = 128, NQ = 768, NKN = 512, DFF = 2816, NUP = 5632;
constexpr float EPS = 1e-6f;
constexpr float C2 = 0.10206207261596575f * 1.4426950408889634f;

constexpr size_t MiB = 1u << 20;
constexpr size_t WS_ADA = 0;
constexpr size_t CTL_ZERO_BYTES = 512 * 1024;
constexpr size_t WS_CNT = 256 * 1024;
constexpr size_t WS_GV = 1 * MiB + 768 * 1024;
constexpr size_t WS_XB = 25 * MiB;
constexpr size_t WS_BAR = 200 * 1024;
constexpr size_t WS_ROPE = 1 * MiB;
constexpr size_t WS_WSP = 1 * MiB + 512 * 1024;
constexpr size_t WS_WIN = 2 * MiB;
constexpr size_t WS_WUQ = 5 * MiB;
constexpr size_t WS_WUK = 5 * MiB + 512 * 1024;
constexpr size_t WS_WUV = 5 * MiB + 768 * 1024;
constexpr size_t WS_WO = 6 * MiB;
constexpr size_t WS_WUP = 8 * MiB;
constexpr size_t WS_WDN = 19 * MiB;
constexpr size_t WS_XN = 32 * MiB;
constexpr size_t WS_Z = 96 * MiB;
constexpr size_t WS_CQN = 192 * MiB;
constexpr size_t WS_CKVN = 208 * MiB;
constexpr size_t WS_KR = 216 * MiB;
constexpr size_t WS_Q = 218 * MiB;
constexpr size_t WS_KN = 266 * MiB;
constexpr size_t WS_VT = 298 * MiB;
constexpr size_t WS_AO = 330 * MiB;
constexpr size_t WS_MB = 394 * MiB;
constexpr size_t WS_SIDE = 96 * MiB;
constexpr size_t WS_ACT = 272 * MiB;
constexpr size_t WS_FB = 448 * MiB;
constexpr size_t WS_END = 512 * MiB;

constexpr int LDS_BYTES = 147456;

struct Args {
    const float* x; const float* c; const float* w_ada; const float* b_ada; const float* g_pre_mix; const float* g_post_mix;
    const float* w_in; const float* g_q; const float* w_uq; const float* g_kv; const float* w_ukv; const float* gm_ln_g; const float* gm_ln_b;
    const float* w_spatial; const float* b_spatial; const float* w_out; const float* g_pre_ffn; const float* g_post_ffn;
    const float* w_up; const float* conv_w; const float* conv_b; const float* w_down;
    float* out; unsigned char* ws;
};

#define CAS __attribute__((address_space(4)))
__device__ __forceinline__ const CAS Args* kargs() { const CAS void* p = (const CAS void*)__builtin_amdgcn_kernarg_segment_ptr(); asm volatile("" : "+s"(p)); return (const CAS Args*)p; }
#define KARGS() const CAS Args* KA = kargs()
__device__ __forceinline__ int otid() { int t = threadIdx.x; asm volatile("" : "+v"(t)); return t; }

namespace pg8 {
#define PG8_LAS __attribute__((address_space(3)))
constexpr int BM = 256, BK = 64, HALF = 128, HTB = HALF * BK * 2, STAGE_BYTES = 8 * HTB, NXCD = 8, WGM = 2;
__host__ __device__ __forceinline__ int lds_byte(int r, int c) { const int st = (r >> 4) * 2 + (c >> 5), rr = r & 15, cc = c & 31, ob = rr * 64 + cc * 2; return st * 1024 + (ob ^ (((ob >> 9) & 1) << 5)); }
__host__ __device__ __forceinline__ void stage_rc(int b, int& R, int& C) { const int st = b / 1024, sb = b % 1024, swz = sb ^ (((sb >> 9) & 1) << 5); R = (st >> 1) * 16 + swz / 64; C = (st & 1) * 32 + (swz % 64) / 2; }
__host__ __device__ __forceinline__ int perm32(int rho) { const int n = rho >> 4, i = rho & 15; return 8 * (i >> 2) + 4 * n + (i & 3); }

__device__ __forceinline__ unsigned cvt_pk_bf16(float lo, float hi) { unsigned r; asm volatile("v_cvt_pk_bf16_f32 %0, %1, %2" : "=v"(r) : "v"(lo), "v"(hi)); return r; }
struct Unit { int pm, pn; };
struct Gemm { const bf16_t* A; const bf16_t* Bt; int M, N, K; };

struct StaticOrder {
    int nM, nN, nwg, G, c;
    __host__ __device__ __forceinline__ void init(int M, int N, int G_, int c_) { nM = M / BM; nN = N / BM; nwg = nM * nN; G = G_; c = c_; }
    __host__ __device__ __forceinline__ bool next(int i, Unit& u) const {
        const long L = (long)i * G + c; if (L >= nwg) return false;
        int wgid = (int)L; { const int q = nwg / NXCD, r = nwg % NXCD, xcd = wgid % NXCD, off = wgid / NXCD; wgid = (xcd < r ? xcd * (q + 1) : r * (q + 1) + (xcd - r) * q) + off; }
        const int nig = WGM * nN, gid = wgid / nig, fm = gid * WGM, gsz = (nM - fm) < WGM ? (nM - fm) : WGM;
        u.pm = fm + ((wgid % nig) % gsz); u.pn = (wgid % nig) / gsz; return true;
    }
    __device__ __forceinline__ void a_ready(const Unit&) const {}
    __device__ __forceinline__ void done(const Unit&) const {}
};

struct EpiBf16 {
    static constexpr bool PERM = true, AFTER_DRAIN = false, NONTRANS = false;
    bf16_t* O; int ldc; int gelu_from;
    __device__ __forceinline__ void operator()(const f32x4 (&acc)[2][2][4][2], const Unit& u, int wr, int wc, int fr, int fq) const {
        const int row0 = u.pm * BM + wr * 64 + fr; const int col0 = u.pn * BM + wc * 32 + 8 * fq;
        const bool act = u.pn >= gelu_from;
#pragma unroll
        for (int ai = 0; ai < 2; ++ai)
#pragma unroll
            for (int m = 0; m < 4; ++m) { bf16_t* rowp = O + (size_t)(row0 + ai * HALF + m * 16) * ldc + col0;
#pragma unroll
                for (int bj = 0; bj < 2; ++bj) { f32x4 v0 = acc[ai][bj][m][0], v1 = acc[ai][bj][m][1];
                    if (act) {
#pragma unroll
                        for (int e = 0; e < 4; ++e) { v0[e] = gelu_tanh(v0[e]); v1[e] = gelu_tanh(v1[e]); } }
                    u32x4 w; w.x = cvt_pk_bf16(v0[0], v0[1]); w.y = cvt_pk_bf16(v0[2], v0[3]); w.z = cvt_pk_bf16(v1[0], v1[1]); w.w = cvt_pk_bf16(v1[2], v1[3]);
                    *(u32x4*)(rowp + bj * HALF) = w; } }
    }
};
struct EpiZ2 {
    static constexpr bool PERM = true, AFTER_DRAIN = false, NONTRANS = false;
    bf16_t* Zo; bf16_t* CQNo; bf16_t* CKVNo; bf16_t* KRo; const float* gq; const float* gkv; const float* rope; PG8_LAS float* P;
    __device__ __forceinline__ void operator()(const f32x4 (&acc)[2][2][4][2], const Unit& u, int wr, int wc, int fr, int fq) const {
        const int row0 = u.pm * BM + wr * 64 + fr;
        if (u.pn >= 2) {
            const int col0 = u.pn * BM + wc * 32 + 8 * fq;
#pragma unroll
            for (int ai = 0; ai < 2; ++ai)
#pragma unroll
                for (int m = 0; m < 4; ++m) { bf16_t* rowp = Zo + (size_t)(row0 + ai * HALF + m * 16) * NZ + col0;
#pragma unroll
                    for (int bj = 0; bj < 2; ++bj) { f32x4 v0 = acc[ai][bj][m][0], v1 = acc[ai][bj][m][1];
#pragma unroll
                        for (int e = 0; e < 4; ++e) { v0[e] = gelu_tanh(v0[e]); v1[e] = gelu_tanh(v1[e]); }
                        u32x4 w; w.x = cvt_pk_bf16(v0[0], v0[1]); w.y = cvt_pk_bf16(v0[2], v0[3]); w.z = cvt_pk_bf16(v1[0], v1[1]); w.w = cvt_pk_bf16(v1[2], v1[3]);
                        *(u32x4*)(rowp + bj * HALF) = w; } }
            return;
        }
        const bool isq = (u.pn == 0);
#pragma unroll
        for (int ai = 0; ai < 2; ++ai)
#pragma unroll
            for (int m = 0; m < 4; ++m) {
                const f32x4 a0 = acc[ai][0][m][0], a1 = acc[ai][0][m][1], b0 = acc[ai][1][m][0], b1 = acc[ai][1][m][1];
                float s = ((a0[0] * a0[0] + a0[1] * a0[1]) + (a0[2] * a0[2] + a0[3] * a0[3])) + ((a1[0] * a1[0] + a1[1] * a1[1]) + (a1[2] * a1[2] + a1[3] * a1[3]));
                if (isq) s += ((b0[0] * b0[0] + b0[1] * b0[1]) + (b0[2] * b0[2] + b0[3] * b0[3])) + ((b1[0] * b1[0] + b1[1] * b1[1]) + (b1[2] * b1[2] + b1[3] * b1[3]));
                s += __shfl_xor(s, 16); s += __shfl_xor(s, 32);
                if (fq == 0) P[(ai * HALF + wr * 64 + m * 16 + fr) * 4 + wc] = s;
            }
        asm volatile("s_waitcnt lgkmcnt(0)" ::: "memory"); __builtin_amdgcn_s_barrier(); asm volatile("" ::: "memory");
        const float invn = isq ? (1.0f / QL) : (1.0f / KVL);
        const int c8 = wc * 32 + 8 * fq;
        const float sgn = (fq < 2) ? -1.0f : 1.0f;
#pragma unroll
        for (int ai = 0; ai < 2; ++ai)
#pragma unroll
            for (int m = 0; m < 4; ++m) {
                const int rl = ai * HALF + wr * 64 + m * 16 + fr; const int row = u.pm * BM + rl;
                const float rs = rsqrtf(((P[rl * 4 + 0] + P[rl * 4 + 1]) + (P[rl * 4 + 2] + P[rl * 4 + 3])) * invn + EPS);
                if (isq) {
#pragma unroll
                    for (int bj = 0; bj < 2; ++bj) { const f32x4 g0 = *(const f32x4*)(gq + bj * HALF + c8), g1 = *(const f32x4*)(gq + bj * HALF + c8 + 4);
                        const f32x4 v0 = acc[ai][bj][m][0] * rs * g0, v1 = acc[ai][bj][m][1] * rs * g1;
                        u32x4 w; w.x = cvt_pk_bf16(v0[0], v0[1]); w.y = cvt_pk_bf16(v0[2], v0[3]); w.z = cvt_pk_bf16(v1[0], v1[1]); w.w = cvt_pk_bf16(v1[2], v1[3]);
                        *(u32x4*)(CQNo + (size_t)row * QL + bj * HALF + c8) = w; }
                } else {
                    { const f32x4 g0 = *(const f32x4*)(gkv + c8), g1 = *(const f32x4*)(gkv + c8 + 4);
                      const f32x4 v0 = acc[ai][0][m][0] * rs * g0, v1 = acc[ai][0][m][1] * rs * g1;
                      u32x4 w; w.x = cvt_pk_bf16(v0[0], v0[1]); w.y = cvt_pk_bf16(v0[2], v0[3]); w.z = cvt_pk_bf16(v1[0], v1[1]); w.w = cvt_pk_bf16(v1[2], v1[3]);
                      *(u32x4*)(CKVNo + (size_t)row * KVL + c8) = w; }
                    if (wc == 0) {
                        f32x4 v0 = acc[ai][1][m][0], v1 = acc[ai][1][m][1];
                        const float* rp = rope + (size_t)(row & (SEQ - 1)) * 32 + 16 * (fq & 1);
                        const f32x4 c0 = *(const f32x4*)rp, c1 = *(const f32x4*)(rp + 4), c2 = *(const f32x4*)(rp + 8), c3 = *(const f32x4*)(rp + 12);
                        const float cs[8] = {c0[0], c0[2], c1[0], c1[2], c2[0], c2[2], c3[0], c3[2]}, sn[8] = {c0[1], c0[3], c1[1], c1[3], c2[1], c2[3], c3[1], c3[3]};
#pragma unroll
                        for (int e = 0; e < 4; ++e) { const float o0 = __shfl_xor(v0[e], 32), o1 = __shfl_xor(v1[e], 32);
                            v0[e] = v0[e] * cs[e] + sgn * o0 * sn[e]; v1[e] = v1[e] * cs[4 + e] + sgn * o1 * sn[4 + e]; }
                        u32x4 w; w.x = cvt_pk_bf16(v0[0], v0[1]); w.y = cvt_pk_bf16(v0[2], v0[3]); w.z = cvt_pk_bf16(v1[0], v1[1]); w.w = cvt_pk_bf16(v1[2], v1[3]);
                        *(u32x4*)(KRo + (size_t)row * 32 + 8 * fq) = w;
                    }
                }
            }
    }
};
struct EpiQ {
    static constexpr bool PERM = true, AFTER_DRAIN = false, NONTRANS = false;
    bf16_t* O; const float* rope;
    __device__ __forceinline__ void operator()(const f32x4 (&acc)[2][2][4][2], const Unit& u, int wr, int wc, int fr, int fq) const {
        const int row0 = u.pm * BM + wr * 64 + fr; const int col0 = u.pn * BM + wc * 32 + 8 * fq;
        const float sgn = (fq < 2) ? -1.0f : 1.0f;
#pragma unroll
        for (int bj = 0; bj < 2; ++bj) {
            const int g32 = 8 * u.pn + 4 * bj + wc; const bool is_rope = (g32 % 3) == 2;
#pragma unroll
            for (int ai = 0; ai < 2; ++ai)
#pragma unroll
                for (int m = 0; m < 4; ++m) {
                    const int row = row0 + ai * HALF + m * 16;
                    f32x4 v0 = acc[ai][bj][m][0] * C2, v1 = acc[ai][bj][m][1] * C2;
                    if (is_rope) {
                        const float* rp = rope + (size_t)(row & (SEQ - 1)) * 32 + 16 * (fq & 1);
                        const f32x4 c0 = *(const f32x4*)rp, c1 = *(const f32x4*)(rp + 4), c2 = *(const f32x4*)(rp + 8), c3 = *(const f32x4*)(rp + 12);
                        const float cs[8] = {c0[0], c0[2], c1[0], c1[2], c2[0], c2[2], c3[0], c3[2]}, sn[8] = {c0[1], c0[3], c1[1], c1[3], c2[1], c2[3], c3[1], c3[3]};
#pragma unroll
                        for (int e = 0; e < 4; ++e) {
                            const float o0 = __shfl_xor(v0[e], 32), o1 = __shfl_xor(v1[e], 32);
                            v0[e] = v0[e] * cs[e] + sgn * o0 * sn[e]; v1[e] = v1[e] * cs[4 + e] + sgn * o1 * sn[4 + e];
                        }
                    }
                    u32x4 w; w.x = cvt_pk_bf16(v0[0], v0[1]); w.y = cvt_pk_bf16(v0[2], v0[3]); w.z = cvt_pk_bf16(v1[0], v1[1]); w.w = cvt_pk_bf16(v1[2], v1[3]);
                    *(u32x4*)(O + (size_t)row * NQ + col0 + bj * HALF) = w;
                }
        }
    }
};

struct EpiConv {
    static constexpr bool PERM = false, AFTER_DRAIN = false, NONTRANS = true;
    bf16_t* ACT; float* SIDE; const float* cw; const float* cb; PG8_LAS float* halo;
    __device__ __forceinline__ void operator()(const f32x4 (&acc)[2][2][4][2], const Unit& u, int wr, int wc, int fr, int fq) const {
        const int lane = threadIdx.x & 63;
        if (fq == 3) {
#pragma unroll
            for (int ai = 0; ai < 2; ++ai)
#pragma unroll
                for (int bj = 0; bj < 2; ++bj)
#pragma unroll
                    for (int n = 0; n < 2; ++n) { PG8_LAS float* hp = halo + (((((ai * 2 + wr) * 4 + wc) * 2 + bj) * 2 + n) * 32) + fr; hp[0] = acc[ai][bj][3][n][2]; hp[16] = acc[ai][bj][3][n][3]; }
        }
        asm volatile("s_waitcnt lgkmcnt(0)" ::: "memory"); __builtin_amdgcn_s_barrier(); asm volatile("" ::: "memory");
        const int j0 = 128 * u.pn + 32 * wc + 2 * fr;
        float wa[2][3], wb[2][3], ba[2], bb[2];
#pragma unroll
        for (int n = 0; n < 2; ++n) {
#pragma unroll
            for (int k = 0; k < 3; ++k) { wa[n][k] = cw[k * NUP + j0 + n]; wb[n][k] = cw[k * NUP + DFF + j0 + n]; }
            ba[n] = cb[j0 + n]; bb[n] = cb[DFF + j0 + n]; }
        const int src = ((lane - 16) & 63) * 4;
#pragma unroll
        for (int ai = 0; ai < 2; ++ai) {
            const int blk = 2 * ai + wr;
#pragma unroll
            for (int m = 0; m < 4; ++m) {
                float o[2][4];
#pragma unroll
                for (int n = 0; n < 2; ++n) {
                    const f32x4 Xa = acc[ai][0][m][n], Xb = acc[ai][1][m][n];
                    float da2, da3, db2, db3;
                    if (m > 0) { const bool t = (fq == 3); da2 = t ? acc[ai][0][m > 0 ? m - 1 : 0][n][2] : Xa[2]; da3 = t ? acc[ai][0][m > 0 ? m - 1 : 0][n][3] : Xa[3];
                                 db2 = t ? acc[ai][1][m > 0 ? m - 1 : 0][n][2] : Xb[2]; db3 = t ? acc[ai][1][m > 0 ? m - 1 : 0][n][3] : Xb[3]; }
                    else { da2 = Xa[2]; da3 = Xa[3]; db2 = Xb[2]; db3 = Xb[3]; }
                    float Ha2 = __builtin_bit_cast(float, __builtin_amdgcn_ds_bpermute(src, __builtin_bit_cast(int, da2)));
                    float Ha3 = __builtin_bit_cast(float, __builtin_amdgcn_ds_bpermute(src, __builtin_bit_cast(int, da3)));
                    float Hb2 = __builtin_bit_cast(float, __builtin_amdgcn_ds_bpermute(src, __builtin_bit_cast(int, db2)));
                    float Hb3 = __builtin_bit_cast(float, __builtin_amdgcn_ds_bpermute(src, __builtin_bit_cast(int, db3)));
                    if (m == 0) {
                        float h2a = 0.f, h3a = 0.f, h2b = 0.f, h3b = 0.f;
                        if (blk > 0) { const PG8_LAS float* hp = halo + ((((blk - 1) * 4 + wc) * 2 + 0) * 2 + n) * 32 + fr; h2a = hp[0]; h3a = hp[16]; h2b = hp[64]; h3b = hp[80]; }
                        if (fq == 0) { Ha2 = h2a; Ha3 = h3a; Hb2 = h2b; Hb3 = h3b; }
                    }
                    const f32x2_t W0 = {wa[n][0], wb[n][0]}, W1 = {wa[n][1], wb[n][1]}, W2 = {wa[n][2], wb[n][2]}, B2 = {ba[n], bb[n]};
                    const f32x2_t H2 = {Ha2, Hb2}, H3 = {Ha3, Hb3}, X0 = {Xa[0], Xb[0]}, X1 = {Xa[1], Xb[1]}, X2 = {Xa[2], Xb[2]}, X3 = {Xa[3], Xb[3]};
                    const f32x2_t y0 = B2 + W0 * H2 + W1 * H3 + W2 * X0, y1 = B2 + W0 * H3 + W1 * X0 + W2 * X1, y2 = B2 + W0 * X0 + W1 * X1 + W2 * X2, y3 = B2 + W0 * X1 + W1 * X2 + W2 * X3;
                    const float ya0 = y0[0], yb0 = y0[1], ya1 = y1[0], yb1 = y1[1], ya2 = y2[0], yb2 = y2[1], ya3 = y3[0], yb3 = y3[1];
                    o[n][0] = silu_f(ya0) * yb0; o[n][1] = silu_f(ya1) * yb1; o[n][2] = silu_f(ya2) * yb2; o[n][3] = silu_f(ya3) * yb3;
                    if (blk == 0 && m == 0 && fq == 0) { float* sp = SIDE + ((size_t)(u.pm * 4 + 0) * 2) * DFF + j0 + n; sp[0] = Xa[0]; sp[DFF] = Xb[0]; sp[2 * DFF] = Xa[1]; sp[3 * DFF] = Xb[1]; }
                    if (blk == 3 && m == 3 && fq == 3) { float* sp = SIDE + ((size_t)(u.pm * 4 + 2) * 2) * DFF + j0 + n; sp[0] = Xa[2]; sp[DFF] = Xb[2]; sp[2 * DFF] = Xa[3]; sp[3 * DFF] = Xb[3]; }
                }
                bf16_t* op = ACT + (size_t)(u.pm * BM + ai * HALF + wr * 64 + m * 16 + 4 * fq) * DFF + j0;
#pragma unroll
                for (int e = 0; e < 4; ++e) *(unsigned*)(op + (size_t)e * DFF) = cvt_pk_bf16(o[0][e], o[1][e]);
            }
        }
    }
};

struct PanelSS {
    float* xbuf; unsigned* cnt; int pm_off; float eps;
    __device__ __forceinline__ void run(const f32x4 (&v)[2][2][4][2], const Unit& u, int wr, int wc, int fr, int fq, PG8_LAS unsigned char* lds, int wid, int lane) const {
        PG8_LAS float* P = (PG8_LAS float*)lds; PG8_LAS float* S = (PG8_LAS float*)(lds + 4096);
        const int pmg = u.pm + pm_off;
#pragma unroll
        for (int ai = 0; ai < 2; ++ai)
#pragma unroll
            for (int m = 0; m < 4; ++m) {
                float s = 0.f;
#pragma unroll
                for (int bj = 0; bj < 2; ++bj)
#pragma unroll
                    for (int n = 0; n < 2; ++n) { const f32x4 x = v[ai][bj][m][n]; s += (x[0] * x[0] + x[1] * x[1]) + (x[2] * x[2] + x[3] * x[3]); }
                s += __shfl_xor(s, 16); s += __shfl_xor(s, 32);
                if (fq == 0) P[(ai * HALF + wr * 64 + m * 16 + fr) * 4 + wc] = s;
            }
        asm volatile("s_waitcnt lgkmcnt(0)" ::: "memory"); __builtin_amdgcn_s_barrier(); asm volatile("" ::: "memory");
        const int row = wid * 32 + (lane & 31);
        if (lane < 32) {
            const float tot = (P[row * 4 + 0] + P[row * 4 + 1]) + (P[row * 4 + 2] + P[row * 4 + 3]);
            __hip_atomic_store(xbuf + ((size_t)(pmg * BM + row) * 4 + u.pn), tot, __ATOMIC_RELAXED, __HIP_MEMORY_SCOPE_AGENT);
        }
        asm volatile("s_waitcnt vmcnt(0)" ::: "memory");
        if (lane == 0) __hip_atomic_fetch_add(cnt + 64 * pmg, 1u, __ATOMIC_RELAXED, __HIP_MEMORY_SCOPE_AGENT);
        if (wid == 0) {
            unsigned sp = 0;
            while ((unsigned)__builtin_amdgcn_readfirstlane(__hip_atomic_load(cnt + 64 * pmg, __ATOMIC_RELAXED, __HIP_MEMORY_SCOPE_AGENT)) < 32u) { __builtin_amdgcn_s_sleep(2); if (++sp > (1u << 22)) break; }
            __builtin_amdgcn_fence(__ATOMIC_ACQUIRE, "agent");
        }
        asm volatile("s_waitcnt vmcnt(0) lgkmcnt(0)" ::: "memory"); __builtin_amdgcn_s_barrier(); asm volatile("" ::: "memory");
        if (lane < 32) {
            const float* slot = xbuf + (size_t)(pmg * BM + row) * 4; float t = 0.f;
#pragma unroll
            for (int k = 0; k < 4; ++k) t += __hip_atomic_load(slot + k, __ATOMIC_RELAXED, __HIP_MEMORY_SCOPE_AGENT);
            S[row] = rsqrtf(t * (1.0f / 1024.0f) + eps);
        }
        asm volatile("s_waitcnt lgkmcnt(0)" ::: "memory"); __builtin_amdgcn_s_barrier(); asm volatile("" ::: "memory");
    }
};
struct EpiRmsRes {
    static constexpr bool PERM = false, AFTER_DRAIN = true, NONTRANS = false;
    const float* base; float* out; const float* gv; int row_off; PanelSS st;
    __device__ __forceinline__ void fused(f32x4 (&acc)[2][2][4][2], const Unit& u, int wr, int wc, int fr, int fq, PG8_LAS unsigned char* lds, int wid, int lane) const {
        const PG8_LAS float* S = (const PG8_LAS float*)(lds + 4096);
        const int col0 = u.pn * BM + wc * 32 + 4 * fq;
        st.run(acc, u, wr, wc, fr, fq, lds, wid, lane);
        f32x4 g[2][2];
#pragma unroll
        for (int bj = 0; bj < 2; ++bj)
#pragma unroll
            for (int n = 0; n < 2; ++n) g[bj][n] = *(const f32x4*)(gv + col0 + bj * HALF + n * 16);
#pragma unroll
        for (int ai = 0; ai < 2; ++ai)
#pragma unroll
            for (int m = 0; m < 4; ++m) { const int r = ai * HALF + wr * 64 + m * 16 + fr; const float rs = S[r]; const size_t off = (size_t)(row_off + u.pm * BM + r) * DM + col0;
#pragma unroll
                for (int bj = 0; bj < 2; ++bj)
#pragma unroll
                    for (int n = 0; n < 2; ++n) { const f32x4 bs = *(const f32x4*)(base + off + bj * HALF + n * 16); __builtin_nontemporal_store(bs + acc[ai][bj][m][n] * rs * g[bj][n], (f32x4*)(out + off + bj * HALF + n * 16)); }
                if (m & 1) asm volatile("" ::: "memory"); }
        asm volatile("s_waitcnt lgkmcnt(0)" ::: "memory"); __builtin_amdgcn_s_barrier(); asm volatile("" ::: "memory");
    }
};

struct EpiRmsResRms {
    static constexpr bool PERM = false, AFTER_DRAIN = true, NONTRANS = false;
    const float* base; float* out; bf16_t* xn; const float* gv1; const float* gv2; const float* sv2; int row_off; PanelSS st1, st2;
    __device__ __forceinline__ void fused(f32x4 (&acc)[2][2][4][2], const Unit& u, int wr, int wc, int fr, int fq, PG8_LAS unsigned char* lds, int wid, int lane) const {
        const PG8_LAS float* S = (const PG8_LAS float*)(lds + 4096);
        const int col0 = u.pn * BM + wc * 32 + 4 * fq;
        st1.run(acc, u, wr, wc, fr, fq, lds, wid, lane);
        {
            f32x4 g[2][2];
#pragma unroll
            for (int bj = 0; bj < 2; ++bj)
#pragma unroll
                for (int n = 0; n < 2; ++n) g[bj][n] = *(const f32x4*)(gv1 + col0 + bj * HALF + n * 16);
#pragma unroll
            for (int ai = 0; ai < 2; ++ai)
#pragma unroll
                for (int m = 0; m < 4; ++m) { const int r = ai * HALF + wr * 64 + m * 16 + fr; const float rs = S[r]; const size_t off = (size_t)(row_off + u.pm * BM + r) * DM + col0;
#pragma unroll
                    for (int bj = 0; bj < 2; ++bj)
#pragma unroll
                        for (int n = 0; n < 2; ++n) { const f32x4 bs = __builtin_nontemporal_load((const f32x4*)(base + off + bj * HALF + n * 16)); acc[ai][bj][m][n] = bs + acc[ai][bj][m][n] * rs * g[bj][n]; }
                    asm volatile("" : "+v"(acc[ai][0][m][0]), "+v"(acc[ai][0][m][1]), "+v"(acc[ai][1][m][0]), "+v"(acc[ai][1][m][1]));
                    if (m & 1) asm volatile("" ::: "memory"); }
        }
        st2.run(acc, u, wr, wc, fr, fq, lds, wid, lane);
        {
            f32x4 g[2][2], sv[2][2];
#pragma unroll
            for (int bj = 0; bj < 2; ++bj)
#pragma unroll
                for (int n = 0; n < 2; ++n) { g[bj][n] = *(const f32x4*)(gv2 + col0 + bj * HALF + n * 16); sv[bj][n] = *(const f32x4*)(sv2 + col0 + bj * HALF + n * 16); }
#pragma unroll
            for (int ai = 0; ai < 2; ++ai)
#pragma unroll
                for (int m = 0; m < 4; ++m) { const int r = ai * HALF + wr * 64 + m * 16 + fr; const float rs = S[r]; const size_t off = (size_t)(row_off + u.pm * BM + r) * DM + col0;
#pragma unroll
                    for (int bj = 0; bj < 2; ++bj)
#pragma unroll
                        for (int n = 0; n < 2; ++n) { const f32x4 x1 = acc[ai][bj][m][n]; *(f32x4*)(out + off + bj * HALF + n * 16) = x1;
                            const f32x4 o = x1 * rs * g[bj][n] + sv[bj][n]; u32x2 w; w.x = cvt_pk_bf16(o[0], o[1]); w.y = cvt_pk_bf16(o[2], o[3]); *(u32x2*)(xn + off + bj * HALF + n * 16) = w; }
                    asm volatile("" ::: "memory"); }
        }
        asm volatile("s_waitcnt lgkmcnt(0)" ::: "memory"); __builtin_amdgcn_s_barrier(); asm volatile("" ::: "memory");
    }
};

template <class Epi, class Sched, bool ALIGN_EPI = false, bool SP2 = false>
__device__ __forceinline__ void gemm_phase(PG8_LAS unsigned char* lds, const Gemm g, const Sched& S, const Epi& E) {
    int tid_ = threadIdx.x; asm volatile("" : "+v"(tid_));
    const int tid = tid_, wid = __builtin_amdgcn_readfirstlane(tid >> 6), lane = tid & 63, wr = wid >> 2, wc = wid & 3, fr = lane & 15, fq = lane >> 4;
    const int K = g.K, nt = K / BK;
    unsigned voffA[2], voffB[2];
#pragma unroll
    for (int i = 0; i < 2; ++i) { int R, C; stage_rc(tid * 16 + i * 8192, R, C); const int Rb = Epi::PERM ? ((R & ~31) + perm32(R & 31)) : R;
        voffA[i] = (unsigned)(R * K + C) * 2u; voffB[i] = (unsigned)(Rb * K + C) * 2u; }
    const size_t kstep = (size_t)(BK * 2);
    const size_t hstep = (size_t)HALF * K * 2;
    const size_t tstep = 2 * hstep;
    const unsigned ldsw = (unsigned)wid * 1024u;
    const int aoff = lds_byte(wr * 64 + fr, fq * 8), boff = lds_byte(wc * 32 + fr, fq * 8);
#define PG8_SA(b, h) (((b) * 2 + (h)) * HTB)
#define PG8_SB(b, h) ((4 + (b) * 2 + (h)) * HTB)
#define PG8_STAGE(bufoff, gbase, voff) do { _Pragma("unroll") for (int _i = 0; _i < 2; ++_i) \
        __builtin_amdgcn_global_load_lds((const unsigned*)((const char*)(gbase) + (voff)[_i]), (PG8_LAS unsigned*)(lds + (bufoff) + ldsw + _i * 8192), 16, 0, 0); } while (0)
#define PG8_LDA(dst, b, h) do { _Pragma("unroll") for (int m = 0; m < 4; ++m) _Pragma("unroll") for (int k = 0; k < 2; ++k) dst[m][k] = *(const PG8_LAS bf16x8*)(lds + PG8_SA(b, h) + aoff + m * 2048 + k * 1024); } while (0)
#define PG8_LDB(dst, b, h) do { _Pragma("unroll") for (int n = 0; n < 2; ++n) _Pragma("unroll") for (int k = 0; k < 2; ++k) dst[n][k] = *(const PG8_LAS bf16x8*)(lds + PG8_SB(b, h) + boff + n * 2048 + k * 1024); } while (0)
#define PG8_MMA(ai, bj, At, Bt) do { __builtin_amdgcn_s_setprio(1); _Pragma("unroll") for (int m = 0; m < 4; ++m) _Pragma("unroll") for (int n = 0; n < 2; ++n) _Pragma("unroll") for (int k = 0; k < 2; ++k) \
        acc[ai][bj][m][n] = Epi::NONTRANS ? __builtin_amdgcn_mfma_f32_16x16x32_bf16(At[m][k], Bt[n][k], acc[ai][bj][m][n], 0, 0, 0) : __builtin_amdgcn_mfma_f32_16x16x32_bf16(Bt[n][k], At[m][k], acc[ai][bj][m][n], 0, 0, 0); __builtin_amdgcn_s_setprio(0); } while (0)
#define PG8_WAIT_V(n) asm volatile("s_waitcnt vmcnt(" #n ")" ::: "memory")
#define PG8_WAIT_L(n) asm volatile("s_waitcnt lgkmcnt(" #n ")" ::: "memory")
#define PG8_BAR __builtin_amdgcn_s_barrier()
#define PG8_SCHED __builtin_amdgcn_sched_barrier(0)
    Unit cur, nxt; int ui = 0;
    if (!S.next(0, cur)) return;
    f32x4 acc[2][2][4][2];
#pragma unroll
    for (int a = 0; a < 2; ++a)
#pragma unroll
        for (int b = 0; b < 2; ++b)
#pragma unroll
            for (int m = 0; m < 4; ++m)
#pragma unroll
                for (int n = 0; n < 2; ++n) acc[a][b][m][n] = (f32x4){0.f, 0.f, 0.f, 0.f};
    bf16x8 At[4][2], B0[2][2], B1[2][2];
    const char* cA = (const char*)g.A + (size_t)cur.pm * tstep; const char* cB = (const char*)g.Bt + (size_t)cur.pn * tstep;
    S.a_ready(cur);
    if constexpr (SP2) {
        PG8_STAGE(PG8_SB(0, 0), cB, voffB); PG8_STAGE(PG8_SB(0, 1), cB + hstep, voffB); PG8_STAGE(PG8_SA(0, 0), cA, voffA); PG8_STAGE(PG8_SA(0, 1), cA + hstep, voffA);
        if (wr == 1) PG8_BAR;
        PG8_WAIT_V(2); PG8_BAR;
        PG8_STAGE(PG8_SB(1, 0), cB + kstep, voffB); PG8_STAGE(PG8_SA(1, 0), cA + kstep, voffA); PG8_STAGE(PG8_SB(1, 1), cB + hstep + kstep, voffB);
        PG8_WAIT_V(6); PG8_BAR;
    } else {
        PG8_STAGE(PG8_SB(0, 0), cB, voffB); PG8_STAGE(PG8_SA(0, 0), cA, voffA); PG8_STAGE(PG8_SB(0, 1), cB + hstep, voffB); PG8_STAGE(PG8_SA(0, 1), cA + hstep, voffA);
        if (wr == 1) PG8_BAR;
        PG8_WAIT_V(4); PG8_BAR;
        PG8_STAGE(PG8_SB(1, 0), cB + kstep, voffB); PG8_STAGE(PG8_SA(1, 0), cA + kstep, voffA); PG8_STAGE(PG8_SB(1, 1), cB + hstep + kstep, voffB);
        PG8_WAIT_V(6); PG8_BAR;
    }
    for (;;) {
        const bool has_next = S.next(ui + 1, nxt);
        const char* nA = has_next ? (const char*)g.A + (size_t)nxt.pm * tstep : cA; const char* nB = has_next ? (const char*)g.Bt + (size_t)nxt.pn * tstep : cB;
        for (int t = 0; t < nt; t += 2) {
            const bool last = (t == nt - 2);
            const char* a1 = cA + (size_t)(t + 1) * kstep;
            const char* a2 = last ? nA : cA + (size_t)(t + 2) * kstep; const char* b2 = last ? nB : cB + (size_t)(t + 2) * kstep;
            const char* a3 = a2 + kstep; const char* b3 = b2 + kstep;
            if (last && has_next) S.a_ready(nxt);
            if constexpr (SP2) {
            PG8_LDB(B0, 0, 0); PG8_LDB(B1, 0, 1); PG8_SCHED; PG8_LDA(At, 0, 0); PG8_STAGE(PG8_SA(1, 1), a1 + hstep, voffA);
            PG8_WAIT_V(8); PG8_WAIT_L(0); PG8_BAR; PG8_MMA(0, 0, At, B0); PG8_MMA(0, 1, At, B1); PG8_BAR; PG8_SCHED;
            PG8_LDA(At, 0, 1); PG8_STAGE(PG8_SB(0, 0), b2, voffB); PG8_STAGE(PG8_SB(0, 1), b2 + hstep, voffB); PG8_STAGE(PG8_SA(0, 0), a2, voffA);
            PG8_WAIT_V(8); PG8_WAIT_L(0); PG8_BAR; PG8_MMA(1, 0, At, B0); PG8_MMA(1, 1, At, B1); PG8_BAR; PG8_SCHED;
            PG8_LDB(B0, 1, 0); PG8_LDB(B1, 1, 1); PG8_SCHED; PG8_LDA(At, 1, 0); PG8_STAGE(PG8_SA(0, 1), a2 + hstep, voffA);
            PG8_WAIT_V(8); PG8_WAIT_L(0); PG8_BAR; PG8_MMA(0, 0, At, B0); PG8_MMA(0, 1, At, B1); PG8_BAR; PG8_SCHED;
            PG8_LDA(At, 1, 1); PG8_STAGE(PG8_SB(1, 0), b3, voffB); PG8_STAGE(PG8_SB(1, 1), b3 + hstep, voffB); PG8_STAGE(PG8_SA(1, 0), a3, voffA);
            PG8_WAIT_V(8); PG8_WAIT_L(0); PG8_BAR; PG8_MMA(1, 0, At, B0); PG8_MMA(1, 1, At, B1); PG8_BAR; PG8_SCHED;
            } else {
            PG8_LDB(B0, 0, 0); PG8_SCHED; PG8_LDA(At, 0, 0); PG8_STAGE(PG8_SA(1, 1), a1 + hstep, voffA);
            PG8_WAIT_L(8); PG8_BAR; PG8_WAIT_L(0); PG8_MMA(0, 0, At, B0); PG8_BAR; PG8_SCHED;
            PG8_LDB(B1, 0, 1); PG8_STAGE(PG8_SB(0, 0), b2, voffB);
            PG8_BAR; PG8_WAIT_L(0); PG8_MMA(0, 1, At, B1); PG8_BAR;
            PG8_LDA(At, 0, 1); PG8_STAGE(PG8_SA(0, 0), a2, voffA);
            PG8_BAR; PG8_WAIT_L(0); PG8_MMA(1, 0, At, B0); PG8_BAR; PG8_SCHED;
            PG8_STAGE(PG8_SB(0, 1), b2 + hstep, voffB);
            PG8_WAIT_V(6); PG8_BAR; PG8_MMA(1, 1, At, B1); PG8_BAR;
            PG8_LDB(B0, 1, 0); PG8_SCHED; PG8_LDA(At, 1, 0); PG8_STAGE(PG8_SA(0, 1), a2 + hstep, voffA);
            PG8_WAIT_L(8); PG8_BAR; PG8_WAIT_L(0); PG8_MMA(0, 0, At, B0); PG8_BAR; PG8_SCHED;
            PG8_LDB(B1, 1, 1); PG8_STAGE(PG8_SB(1, 0), b3, voffB);
            PG8_BAR; PG8_WAIT_L(0); PG8_MMA(0, 1, At, B1); PG8_BAR;
            PG8_LDA(At, 1, 1); PG8_STAGE(PG8_SA(1, 0), a3, voffA);
            PG8_BAR; PG8_WAIT_L(0); PG8_MMA(1, 0, At, B0); PG8_BAR; PG8_SCHED;
            PG8_STAGE(PG8_SB(1, 1), b3 + hstep, voffB);
            PG8_WAIT_V(6); PG8_BAR; PG8_MMA(1, 1, At, B1); PG8_BAR;
            }
        }
        if constexpr (ALIGN_EPI) { if (wr == 0) PG8_BAR; }
        if constexpr (!Epi::AFTER_DRAIN) { E(acc, cur, wr, wc, fr, fq); S.done(cur); }
        if (!has_next) break;
#pragma unroll
        for (int a = 0; a < 2; ++a)
#pragma unroll
            for (int b = 0; b < 2; ++b)
#pragma unroll
                for (int m = 0; m < 4; ++m)
#pragma unroll
                    for (int n = 0; n < 2; ++n) acc[a][b][m][n] = (f32x4){0.f, 0.f, 0.f, 0.f};
        cur = nxt; cA = nA; cB = nB; ++ui;
        if constexpr (ALIGN_EPI) { if (wr == 1) PG8_BAR; }
    }
    PG8_WAIT_V(0);
    if constexpr (!ALIGN_EPI) { if (wr == 0) PG8_BAR; }
    PG8_BAR;
    if constexpr (Epi::AFTER_DRAIN) { E.fused(acc, cur, wr, wc, fr, fq, lds, wid, lane); S.done(cur); }
#undef PG8_SA
#undef PG8_SB
#undef PG8_STAGE
#undef PG8_LDA
#undef PG8_LDB
#undef PG8_MMA
#undef PG8_WAIT_V
#undef PG8_WAIT_L
#undef PG8_BAR
#undef PG8_SCHED
}
}
#define XB_TMO      128
#define XB_XCNT(j)  (256  + 64 * (j))
#define XB_XSUB(j)  (1280 + 64 * (j))
#define XB_XGEN(j)  (2304 + 64 * (j))
#define XB_TOP      3328
#define XB_TOPGEN   3392
#define XCD_BAR_WORDS 3456
#define XB_SPIN_CAP (1u << 18)

__device__ __forceinline__ unsigned xb_ld(unsigned* p)              { return __hip_atomic_load(p, __ATOMIC_RELAXED, __HIP_MEMORY_SCOPE_AGENT); }
__device__ __forceinline__ unsigned xb_add(unsigned* p, unsigned v) { return __hip_atomic_fetch_add(p, v, __ATOMIC_RELAXED, __HIP_MEMORY_SCOPE_AGENT); }
__device__ __forceinline__ unsigned xb_xcc_id() { return (unsigned)__builtin_amdgcn_s_getreg((3 << 11) | 20) & 0xFu; }
#define XB_SPIN(cond, bar) do { unsigned _sp = 0; while (cond) { __builtin_amdgcn_s_sleep(1); \
    if ((++_sp & 255u) == 0u) { if (xb_ld(&(bar)[XB_TMO])) break; if (_sp > XB_SPIN_CAP) { atomicAdd(&(bar)[XB_TMO], 1u); break; } } } } while (0)

struct XcdBarrier {
    unsigned* bar; unsigned x;
    volatile LAS unsigned* st;
};

__device__ __forceinline__ XcdBarrier xcd_barrier_post(unsigned* bar, volatile LAS unsigned* st) {
    XcdBarrier b; b.bar = bar; b.x = xb_xcc_id(); b.st = st;
    if (threadIdx.x == 0) (void)xb_add(&bar[XB_XCNT(b.x)], 1u);
    return b;
}
__device__ __forceinline__ void xcd_barrier_complete(unsigned* bar, unsigned x, unsigned& nloc, unsigned& nx) {
    const unsigned G = gridDim.x * gridDim.y * gridDim.z;
    unsigned sum, cnt, mine, sp = 0u;
    for (;;) {
        sum = 0u; cnt = 0u; mine = 0u;
#pragma unroll 1
        for (unsigned j = 0; j < 16; ++j) { const unsigned c = xb_ld(&bar[XB_XCNT(j)]); sum += c; cnt += (c > 0u) ? 1u : 0u; mine = (j == x) ? c : mine; }
        if (sum == G) break;
        __builtin_amdgcn_s_sleep(1);
        if ((++sp & 255u) == 0u) { if (xb_ld(&bar[XB_TMO])) break; if (sp > XB_SPIN_CAP) { atomicAdd(&bar[XB_TMO], 1u); break; } }
    }
    nloc = mine > 0u ? mine : 1u; nx = cnt > 0u ? cnt : 1u;
}

__device__ __forceinline__ void xcd_barrier(const XcdBarrier& b) {
    asm volatile("s_waitcnt vmcnt(0)" ::: "memory");
    __syncthreads();
    if (threadIdx.x == 0) {
        unsigned* bar = b.bar;
        __builtin_amdgcn_s_waitcnt(0);
        unsigned nloc = b.st[0], nx = b.st[1];
        if (nloc == 0u) { xcd_barrier_complete(bar, b.x, nloc, nx); b.st[0] = nloc; b.st[1] = nx; }
        const unsigned old = xb_add(&bar[XB_XSUB(b.x)], 1u);
        const unsigned gen = old / nloc;
        if (old + 1u == (gen + 1u) * nloc) {
            __builtin_amdgcn_fence(__ATOMIC_RELEASE, "agent");
            asm volatile("s_waitcnt vmcnt(0)" ::: "memory");
            const unsigned og = xb_add(&bar[XB_TOP], 1u);
            const unsigned tg = og / nx;
            if (og + 1u == (tg + 1u) * nx) xb_add(&bar[XB_TOPGEN], 1u);
            else XB_SPIN(xb_ld(&bar[XB_TOPGEN]) == tg, bar);
            __builtin_amdgcn_fence(__ATOMIC_ACQUIRE, "agent");
            xb_add(&bar[XB_XGEN(b.x)], 1u);
            asm volatile("s_waitcnt vmcnt(0)" ::: "memory");
        } else {
            XB_SPIN(xb_ld(&bar[XB_XGEN(b.x)]) == gen, bar);
            __builtin_amdgcn_fence(__ATOMIC_ACQUIRE, "agent");
            asm volatile("s_waitcnt vmcnt(0)" ::: "memory");
        }
    }
    __syncthreads();
}

__device__ __forceinline__ void tr_item(const float* __restrict__ W, int K, int N, bf16_t* WT, int k0, int n0, int drow0, LAS float* scr, int lane, bool perm = false) {
#pragma unroll 8
    for (int i = 0; i < 32; ++i) { const int kk = 2 * i + (lane >> 5); scr[kk * 33 + (lane & 31)] = W[(size_t)(k0 + kk) * N + n0 + (lane & 31)]; }
    asm volatile("s_waitcnt lgkmcnt(0)" ::: "memory");
    const int c = lane & 7;
#pragma unroll
    for (int j = 0; j < 4; ++j) { const int n = (lane >> 3) + 8 * j; const LAS float* s = scr + (8 * c) * 33 + n;
        u32x4 o; o.x = pk2(s[0 * 33], s[1 * 33]); o.y = pk2(s[2 * 33], s[3 * 33]); o.z = pk2(s[4 * 33], s[5 * 33]); o.w = pk2(s[6 * 33], s[7 * 33]);
        *(u32x4*)(WT + (size_t)(drow0 + (perm ? 16 * (n & 1) + (n >> 1) : n)) * K + k0 + 8 * c) = o; }
    asm volatile("s_waitcnt lgkmcnt(0)" ::: "memory");
}

typedef float f32x2v __attribute__((ext_vector_type(2)));
__device__ __forceinline__ float max3f(float a, float b, float c) { return fmaxf(fmaxf(a, b), c); }
__device__ __forceinline__ void attn_ldk(bf16x8 (&kf)[12], const LAS unsigned char* kb) {
    constexpr int KP = 104;
#pragma unroll
    for (int ks = 0; ks < 6; ++ks) { kf[2 * ks] = *(const LAS bf16x8*)(kb + 32 * ks); kf[2 * ks + 1] = *(const LAS bf16x8*)(kb + 32 * KP * 2 + 32 * ks); }
}
__device__ __forceinline__ void attn_ldv(bf16x8 (&vf)[8], const LAS unsigned char* vb) {
    constexpr int VP = 136;
#pragma unroll
    for (int s = 0; s < 4; ++s) { vf[2 * s] = *(const LAS bf16x8*)(vb + 32 * s); vf[2 * s + 1] = *(const LAS bf16x8*)(vb + 32 * VP * 2 + 32 * s); }
}
__device__ __forceinline__ void attn_qk(f32x16& p0, f32x16& p1, const bf16x8 (&kf)[12], const bf16x8 (&qf)[6]) {
    const f32x16 zero = {0.f, 0.f, 0.f, 0.f, 0.f, 0.f, 0.f, 0.f, 0.f, 0.f, 0.f, 0.f, 0.f, 0.f, 0.f, 0.f};
#pragma unroll
    for (int ks = 0; ks < 6; ++ks) {
        p0 = __builtin_amdgcn_mfma_f32_32x32x16_bf16(kf[2 * ks], qf[ks], ks == 0 ? zero : p0, 0, 0, 0);
        p1 = __builtin_amdgcn_mfma_f32_32x32x16_bf16(kf[2 * ks + 1], qf[ks], ks == 0 ? zero : p1, 0, 0, 0);
    }
}
__device__ __forceinline__ void attn_softmax(f32x16& p0, f32x16& p1, bf16x8 (&pb)[4], f32x16& o0, f32x16& o1, float& m_run, float& l_run) {
    float mx = max3f(p0[0], p0[1], p1[0]), my = max3f(p0[2], p0[3], p1[1]);
    mx = max3f(mx, p1[2], p1[3]);
#pragma unroll
    for (int r = 4; r < 16; r += 4) { mx = max3f(mx, p0[r], p0[r + 1]); my = max3f(my, p0[r + 2], p0[r + 3]); mx = max3f(mx, p1[r], p1[r + 1]); my = max3f(my, p1[r + 2], p1[r + 3]); }
    mx = fmaxf(mx, my);
    { auto rr = __builtin_amdgcn_permlane32_swap(__float_as_uint(mx), __float_as_uint(mx), false, false); mx = fmaxf(__uint_as_float(rr[0]), __uint_as_float(rr[1])); }
    const float m_new = fmaxf(m_run, mx);
    const float alpha = __builtin_amdgcn_exp2f(m_run - m_new);
    m_run = m_new;
    p0 = p0 - m_new; p1 = p1 - m_new;
#pragma unroll
    for (int r = 0; r < 16; ++r) { p0[r] = __builtin_amdgcn_exp2f(p0[r]); p1[r] = __builtin_amdgcn_exp2f(p1[r]); }
    f32x16 sm = p0 + p1;
    f32x2v s2 = (f32x2v){sm[0], sm[1]} + (f32x2v){sm[2], sm[3]};
#pragma unroll
    for (int r = 4; r < 16; r += 2) s2 += (f32x2v){sm[r], sm[r + 1]};
    l_run = l_run * alpha + (s2[0] + s2[1]);
    o0 = o0 * alpha; o1 = o1 * alpha;
#pragma unroll
    for (int s = 0; s < 2; ++s) {
        u32x4 w; w.x = pk2(p0[8 * s], p0[8 * s + 1]); w.y = pk2(p0[8 * s + 2], p0[8 * s + 3]); w.z = pk2(p0[8 * s + 4], p0[8 * s + 5]); w.w = pk2(p0[8 * s + 6], p0[8 * s + 7]);
        pb[s] = __builtin_bit_cast(bf16x8, w);
        u32x4 w2; w2.x = pk2(p1[8 * s], p1[8 * s + 1]); w2.y = pk2(p1[8 * s + 2], p1[8 * s + 3]); w2.z = pk2(p1[8 * s + 4], p1[8 * s + 5]); w2.w = pk2(p1[8 * s + 6], p1[8 * s + 7]);
        pb[2 + s] = __builtin_bit_cast(bf16x8, w2);
    }
}
__device__ __forceinline__ void attn_pv(const bf16x8 (&vf)[8], const bf16x8 (&pb)[4], f32x16& o0, f32x16& o1) {
#pragma unroll
    for (int s = 0; s < 4; ++s) {
        o0 = __builtin_amdgcn_mfma_f32_32x32x16_bf16(vf[2 * s], pb[s], o0, 0, 0, 0);
        o1 = __builtin_amdgcn_mfma_f32_32x32x16_bf16(vf[2 * s + 1], pb[s], o1, 0, 0, 0);
    }
}
__device__ __forceinline__ void attn_phase(LAS unsigned char* lds, const bf16_t* __restrict__ Q, const bf16_t* __restrict__ KN, const bf16_t* __restrict__ KR,
                                           const bf16_t* __restrict__ VT, bf16_t* AO, int vcu, int G, int tid, int lane, int wave) {
    constexpr int KP = 104, VP = 136, KBUF = 128 * KP * 2, VBUF = 64 * VP * 2, BUF = KBUF + VBUF;
    if (wave >= 4) __builtin_amdgcn_s_setprio(1);
    const int r32 = lane & 31, hi = lane >> 5;
    const int pr = (r32 & ~12) | ((r32 & 4) << 1) | ((r32 & 8) >> 1);
    const int key_l = tid >> 3, kc = tid & 7, key_r = tid >> 2, rc = tid & 3, vd = tid >> 3, vc = tid & 7;
    for (int p = vcu; p < 512; p += G) {
#pragma unroll 1
        for (int half = 0; half < 2; ++half) {
            const int bh = p >> 3, pp = p & 7, qb = half ? 15 - pp : pp, b = bh >> 3, h = bh & 7;
            const size_t rowbase = (size_t)b * SEQ;
            const int qrow0 = qb * 256 + wave * 32, qc = qrow0 >> 6, NT2 = 2 * qb + 2;
            bf16x8 qf[6];
            { const bf16_t* qp = Q + (rowbase + qrow0 + r32) * NQ + h * 96 + 8 * hi;
#pragma unroll
              for (int ks = 0; ks < 6; ++ks) qf[ks] = *(const bf16x8*)(qp + 16 * ks); }
            const char* kbase = (const char*)(KN + rowbase * NKN + h * 64); const unsigned koff = (unsigned)(key_l * NKN + 8 * kc) * 2u;
            const char* rbase = (const char*)(KR + rowbase * 32); const unsigned roff = (unsigned)(key_r * 32 + 8 * rc) * 2u;
            const char* vbase = (const char*)(VT + (size_t)(h * 64) * MTOK + rowbase); const unsigned voff = (unsigned)((size_t)vd * MTOK + 8 * vc) * 2u;
            const int kdst = (key_l * KP + 8 * kc) * 2, rdst = (key_r * KP + 64 + 8 * rc) * 2, vdst = KBUF + (vd * VP + 8 * vc) * 2;
            u32x4 gk0, gk1, gr, gv0, gv1;
            gk0 = *(const u32x4*)(kbase + koff); gk1 = *(const u32x4*)(kbase + 64 * NKN * 2 + koff); gr = *(const u32x4*)(rbase + roff); gv0 = *(const u32x4*)(vbase + voff); gv1 = *(const u32x4*)(vbase + 128 + voff);
            *(LAS u32x4*)(lds + kdst) = gk0; *(LAS u32x4*)(lds + kdst + 64 * KP * 2) = gk1; *(LAS u32x4*)(lds + rdst) = gr; *(LAS u32x4*)(lds + vdst) = gv0; *(LAS u32x4*)(lds + vdst + 128) = gv1;
            __syncthreads();
            float m_run = -INFINITY, l_run = 0.f;
            f32x16 o0, o1;
#pragma unroll
            for (int r = 0; r < 16; ++r) { o0[r] = 0.f; o1[r] = 0.f; }
#define PREFETCH_NEXT() do { if (more) { const size_t ko = (size_t)(t + 1) * 128;                     const char* kb2 = kbase + ko * NKN * 2; const char* rb2 = rbase + ko * 64; const char* vb2 = vbase + ko * 2;                     gk0 = *(const u32x4*)(kb2 + koff); gk1 = *(const u32x4*)(kb2 + 64 * NKN * 2 + koff); gr = *(const u32x4*)(rb2 + roff); gv0 = *(const u32x4*)(vb2 + voff); gv1 = *(const u32x4*)(vb2 + 128 + voff); } } while (0)
            for (int t = 0; t < NT2; ++t) {
                const bool more = (t + 1 < NT2);
                const LAS unsigned char* buf = lds + (t & 1) * BUF;
                const LAS unsigned char* kA = buf + (pr * KP + 8 * hi) * 2; const LAS unsigned char* vA = buf + KBUF + (r32 * VP + 8 * hi) * 2;
                if (2 * t + 1 <= qc) {
                    bf16x8 kf[12], kf2[12], vf[8], vf2[8], pa[4], pb2[4]; f32x16 a0, a1, b0, b1;
                    attn_ldk(kf, kA);
                    __builtin_amdgcn_sched_barrier(0);
                    attn_qk(a0, a1, kf, qf);
                    attn_ldk(kf2, kA + 64 * KP * 2);
                    __builtin_amdgcn_sched_barrier(0);
                    attn_qk(b0, b1, kf2, qf);
                    attn_softmax(a0, a1, pa, o0, o1, m_run, l_run);
                    attn_ldv(vf, vA);
                    __builtin_amdgcn_sched_barrier(0);
                    PREFETCH_NEXT();
                    attn_ldv(vf2, vA + 128);
                    __builtin_amdgcn_sched_barrier(0);
                    attn_pv(vf, pa, o0, o1);
                    attn_softmax(b0, b1, pb2, o0, o1, m_run, l_run);
                    __builtin_amdgcn_sched_barrier(0);
                    attn_pv(vf2, pb2, o0, o1);
                } else if (2 * t <= qc) {
                    bf16x8 kf[12], vf[8], pa[4]; f32x16 a0, a1;
                    PREFETCH_NEXT();
                    attn_ldk(kf, kA);
                    __builtin_amdgcn_sched_barrier(0);
                    attn_qk(a0, a1, kf, qf);
                    __builtin_amdgcn_sched_barrier(0);
                    attn_ldv(vf, vA);
                    __builtin_amdgcn_sched_barrier(0);
                    attn_softmax(a0, a1, pa, o0, o1, m_run, l_run);
                    __builtin_amdgcn_sched_barrier(0);
                    attn_pv(vf, pa, o0, o1);
                } else { PREFETCH_NEXT(); }
                if (more) { LAS unsigned char* nb = lds + ((t + 1) & 1) * BUF;
                    *(LAS u32x4*)(nb + kdst) = gk0; *(LAS u32x4*)(nb + kdst + 64 * KP * 2) = gk1; *(LAS u32x4*)(nb + rdst) = gr; *(LAS u32x4*)(nb + vdst) = gv0; *(LAS u32x4*)(nb + vdst + 128) = gv1; }
                __syncthreads();
            }
            const float l = l_run + __shfl_xor(l_run, 32);
            const float inv = 1.0f / l;
            bf16_t* op = AO + (rowbase + qrow0 + r32) * DM + h * 64 + 8 * hi;
#pragma unroll
            for (int blk_ = 0; blk_ < 2; ++blk_) {
#pragma unroll
                for (int k2 = 0; k2 < 2; ++k2) {
                    const int g0 = 2 * k2, g1 = 2 * k2 + 1;
                    unsigned x0, x1, y0, y1;
                    if (blk_ == 0) { x0 = pk2(o0[4 * g0] * inv, o0[4 * g0 + 1] * inv); x1 = pk2(o0[4 * g0 + 2] * inv, o0[4 * g0 + 3] * inv); y0 = pk2(o0[4 * g1] * inv, o0[4 * g1 + 1] * inv); y1 = pk2(o0[4 * g1 + 2] * inv, o0[4 * g1 + 3] * inv); }
                    else           { x0 = pk2(o1[4 * g0] * inv, o1[4 * g0 + 1] * inv); x1 = pk2(o1[4 * g0 + 2] * inv, o1[4 * g0 + 3] * inv); y0 = pk2(o1[4 * g1] * inv, o1[4 * g1 + 1] * inv); y1 = pk2(o1[4 * g1 + 2] * inv, o1[4 * g1 + 3] * inv); }
                    const auto s0 = __builtin_amdgcn_permlane32_swap(x0, y0, false, false);
                    const auto s1 = __builtin_amdgcn_permlane32_swap(x1, y1, false, false);
                    u32x4 w; w.x = s0[0]; w.y = s1[0]; w.z = s0[1]; w.w = s1[1];
                    *(u32x4*)(op + 32 * blk_ + 16 * k2) = w;
                }
            }
        }
    }
    __builtin_amdgcn_s_setprio(0);
}

#undef PREFETCH_NEXT
__global__ void __launch_bounds__(512, 2) mega_fwd(Args a) {
    extern __shared__ __attribute__((aligned(16))) unsigned char lds_raw[];
    LAS unsigned char* lds = (LAS unsigned char*)lds_raw;
    cg::grid_group grid = cg::this_grid();
    if (threadIdx.x < 16) ((LAS unsigned*)(lds + 131072))[threadIdx.x] = 0u;
    __syncthreads();
    XcdBarrier xbar; { KARGS(); xbar = xcd_barrier_post((unsigned*)(KA->ws + WS_BAR), (volatile LAS unsigned*)(lds + 131072)); }
#define tid (otid())
#define lane (otid() & 63)
#define wave (__builtin_amdgcn_readfirstlane((int)(threadIdx.x >> 6)))
#define G ((int)gridDim.x)
#define bx ((int)blockIdx.x)
#define vcu ((G % 8 == 0) ? (bx % 8) * (G / 8) + bx / 8 : bx)
#define gw (vcu * 8 + wave)
#define NGW (G * 8)
#define gid (bx * 512 + tid)
#define NT_ALL (G * 512)
#define ws (KA->ws)
#define ADA ((float*)(ws + WS_ADA))
#define ROPE ((float*)(ws + WS_ROPE))
#define WSP ((bf16_t*)(ws + WS_WSP))
#define WIN ((bf16_t*)(ws + WS_WIN))
#define WUQ ((bf16_t*)(ws + WS_WUQ))
#define WUK ((bf16_t*)(ws + WS_WUK))
#define WUV ((bf16_t*)(ws + WS_WUV))
#define WO ((bf16_t*)(ws + WS_WO))
#define WUP ((bf16_t*)(ws + WS_WUP))
#define WDN ((bf16_t*)(ws + WS_WDN))
#define XN ((bf16_t*)(ws + WS_XN))
#define Z ((bf16_t*)(ws + WS_Z))
#define CQN ((bf16_t*)(ws + WS_CQN))
#define CKVN ((bf16_t*)(ws + WS_CKVN))
#define KR ((bf16_t*)(ws + WS_KR))
#define Q ((bf16_t*)(ws + WS_Q))
#define KN ((bf16_t*)(ws + WS_KN))
#define VT ((bf16_t*)(ws + WS_VT))
#define AO ((bf16_t*)(ws + WS_AO))
#define MB ((bf16_t*)(ws + WS_MB))
#define SIDE ((float*)(ws + WS_SIDE))
#define ACT ((bf16_t*)(ws + WS_ACT))
#define FB ((bf16_t*)(ws + WS_FB))
    { KARGS();
    {
        LAS float* cact = (LAS float*)lds;
        for (int i = tid; i < NB * DM; i += 512) cact[i] = silu_f(KA->c[i]);
        __syncthreads();
        for (int it = gw; it < 768; it += NGW) {
            const int cb = it % 24, kc = it / 24, n0 = cb * 256 + lane * 4, k0 = kc * 32;
            f32x4 acc[8];
#pragma unroll
            for (int b = 0; b < 8; ++b) acc[b] = (f32x4){0.f, 0.f, 0.f, 0.f};
#pragma unroll 8
            for (int kk = 0; kk < 32; ++kk) {
                const f32x4 w = *(const f32x4*)(KA->w_ada + (size_t)(k0 + kk) * 6144 + n0);
#pragma unroll
                for (int b = 0; b < 8; ++b) acc[b] += cact[b * DM + k0 + kk] * w;
            }
            if (kc == 0) { const f32x4 bv = *(const f32x4*)(KA->b_ada + n0);
#pragma unroll
                for (int b = 0; b < 8; ++b) acc[b] += bv; }
#pragma unroll
            for (int b = 0; b < 8; ++b)
#pragma unroll
                for (int e = 0; e < 4; ++e) __hip_atomic_fetch_add(ADA + b * 6144 + n0 + e, acc[b][e], __ATOMIC_RELAXED, __HIP_MEMORY_SCOPE_AGENT);
        }
        __syncthreads();
        LAS float* scr = (LAS float*)(lds + wave * 16384);
#pragma unroll 1
        for (int rep0_ = 0; rep0_ < (PROBE == 12 ? 2 : 1); ++rep0_) {
        constexpr int I_IN = 16 * 45, I_UQ = 4 * 24, I_UKV = 2 * 32, I_O = 16 * 32, I_UP = 16 * 176, I_DN = 44 * 32;
        constexpr int NITEMS = I_IN + I_UQ + I_UKV + I_O + I_UP + I_DN;
        for (int it = (gw + NGW - (768 % NGW)) % NGW; it < NITEMS; it += NGW) {
            int r = it;
            if (r < I_IN) { const int kb = r / 45, n0 = 32 * (r % 45); tr_item(KA->w_in, DM, 1440, WIN, 64 * kb, n0, n0 + (n0 >= 416 ? 96 : 0), scr, lane); continue; } r -= I_IN;
            if (r < I_UQ) { const int kb = r / 24, n0 = 32 * (r % 24); tr_item(KA->w_uq, QL, NQ, WUQ, 64 * kb, n0, n0, scr, lane); continue; } r -= I_UQ;
            if (r < I_UKV) { const int kb = r / 32, n0 = 32 * (r % 32); const int hh = n0 >> 7, q4 = (n0 & 127) >> 5;
                tr_item(KA->w_ukv, KVL, 1024, q4 < 2 ? WUK : WUV, 64 * kb, n0, hh * 64 + 32 * (q4 & 1), scr, lane); continue; } r -= I_UKV;
            if (r < I_O) { const int kb = r / 32, n0 = 32 * (r % 32); tr_item(KA->w_out, DM, DM, WO, 64 * kb, n0, n0, scr, lane); continue; } r -= I_O;
            if (r < I_UP) { const int kb = r / 176, n0 = 32 * (r % 176); const int isb = n0 >= DFF, j = isb ? n0 - DFF : n0;
                tr_item(KA->w_up, DM, NUP, WUP, 64 * kb, n0, 256 * (j >> 7) + 128 * isb + (j & 127), scr, lane, true); continue; } r -= I_UP;
            { const int kb = r / 32, n0 = 32 * (r % 32); tr_item(KA->w_down, DFF, DM, WDN, 64 * kb, n0, n0, scr, lane); }
        }
        for (int i = gid; i < 96 * 1024 / 8; i += NT_ALL) *(u32x4*)(WIN + (size_t)416 * 1024 + (size_t)i * 8) = (u32x4){0u, 0u, 0u, 0u};
        for (int i = gid; i < 8 * 128 * 128; i += NT_ALL) { const int ii = (i >> 7) & 127, jj = i & 127; const float v = ((jj >> 6) <= (ii >> 6)) ? KA->w_spatial[i] : 0.f; WSP[i] = (bf16_t)(pk2(v, 0.f) & 0xffffu); }
        for (int i = gid; i < SEQ * 16; i += NT_ALL) { const int s = i >> 4, f = i & 15;
            const float inv = exp2f(-(float)f * (13.287712379549449f / 16.0f));
            const float ang = (float)s * inv;
            const double rev = (double)ang * 0.15915494309189535; const float fr = (float)(rev - floor(rev));
            ROPE[2 * i] = __builtin_amdgcn_cosf(fr); ROPE[2 * i + 1] = __builtin_amdgcn_sinf(fr); }
        }
    }
    }
    { KARGS(); if (KA->out == nullptr) grid.sync(); }
    GSYNC();

    { KARGS();
    for (int idx = gid; idx < NB * DM; idx += NT_ALL) { const int b = idx >> 10, c = idx & 1023; const float* ad = ADA + b * 6144; float* gvp = (float*)(ws + WS_GV);
        gvp[idx] = KA->g_post_mix[c] * ad[2048 + c]; gvp[8192 + idx] = KA->g_pre_ffn[c] * (1.0f + ad[4096 + c]); gvp[16384 + idx] = ad[3072 + c]; gvp[24576 + idx] = KA->g_post_ffn[c] * ad[5120 + c]; }

#pragma unroll 1
    for (int rep_ = 0; rep_ < (PROBE == 7 ? 2 : 1); ++rep_) {
    for (int r0 = gw * 16; r0 < MTOK; r0 += NGW * 16) {
        const int b = r0 >> 12; const float* ad = ADA + b * 6144;
        f32x4 A1[4], B1[4];
#pragma unroll
        for (int j = 0; j < 4; ++j) { const int c = 4 * lane + 256 * j; const f32x4 g = *(const f32x4*)(KA->g_pre_mix + c), sc = *(const f32x4*)(ad + 1024 + c); A1[j] = g * (1.0f + sc); B1[j] = *(const f32x4*)(ad + c); }
        f32x4 vn[4];
#pragma unroll
        for (int j = 0; j < 4; ++j) vn[j] = __builtin_nontemporal_load((const f32x4*)(KA->x + (size_t)r0 * DM + 4 * lane + 256 * j));
        for (int rr = 0; rr < 16; ++rr) {
            const size_t row = (size_t)(r0 + rr), nrow = (size_t)(r0 + (rr < 15 ? rr + 1 : 15));
            f32x4 v[4]; float ss = 0.f;
#pragma unroll
            for (int j = 0; j < 4; ++j) { v[j] = vn[j]; vn[j] = __builtin_nontemporal_load((const f32x4*)(KA->x + nrow * DM + 4 * lane + 256 * j)); ss += (v[j][0] * v[j][0] + v[j][1] * v[j][1]) + (v[j][2] * v[j][2] + v[j][3] * v[j][3]); }
            const float rs = rsqrtf(wave_sum(ss) * (1.0f / DM) + EPS);
#pragma unroll
            for (int j = 0; j < 4; ++j) { const f32x4 o = v[j] * rs * A1[j] + B1[j]; u32x2 w; w.x = pk2(o[0], o[1]); w.y = pk2(o[2], o[3]); *(u32x2*)(XN + row * DM + 4 * lane + 256 * j) = w; }
        }
    }
    }
    }
    GSYNC();

    { KARGS();
#pragma unroll 1
    for (int rep_ = 0; rep_ < (PROBE == 10 ? 2 : 1); ++rep_) {
    { pg8::Gemm g{XN, WIN, MTOK, NZ, DM}; pg8::StaticOrder S; S.init(MTOK, NZ, G, bx); pg8::EpiZ2 E{Z, CQN, CKVN, KR, KA->g_q, KA->g_kv, ROPE, (LAS float*)(lds + 131072 + 1024)};
      pg8::gemm_phase<pg8::EpiZ2, pg8::StaticOrder, true, true>(lds, g, S, E); }
    }
    }
    GSYNC();

    { KARGS();
#pragma unroll 1
    for (int rep_ = 0; rep_ < (PROBE == 3 ? 2 : 1); ++rep_) {
    {
        constexpr int VLP = 136;
        LAS bf16_t* VLT = (LAS bf16_t*)lds;
        const int r32 = lane & 31, hi = lane >> 5, iblk = wave >> 1, dblk = wave & 1;
        const int jt = tid >> 2, qd = tid & 3;
        u32x4 r0, r1; f32x4 lgv[4], lbv[4];
        const int ustep = (G == 256) ? 1 : G;
        const int jx = vcu & 31;
        const int u0 = (G == 256) ? (256 * (vcu >> 5) + (jx < 16 ? 7 * jx : 112 + 9 * (jx - 16))) : vcu;
        const int ucnt = (G == 256) ? (bx < 128 ? 7 : 9) : (vcu < 2048 ? (2047 - vcu) / G + 1 : 0);
        if (ucnt > 0) { const bf16_t* vp = Z + ((size_t)(u0 >> 3) * 128 + jt) * NZ + 1024 + (u0 & 7) * 64 + 16 * qd; r0 = *(const u32x4*)vp; r1 = *(const u32x4*)(vp + 8);
#pragma unroll
            for (int e4 = 0; e4 < 4; ++e4) { lgv[e4] = *(const f32x4*)(KA->gm_ln_g + (u0 & 7) * 64 + 16 * qd + 4 * e4); lbv[e4] = *(const f32x4*)(KA->gm_ln_b + (u0 & 7) * 64 + 16 * qd + 4 * e4); } }
        for (int ui = 0, u = u0; ui < ucnt; ++ui, u += ustep) {
            const int blk = u >> 3, h = u & 7; const size_t t0 = (size_t)blk * 128;
            {
                float xv[16];
                xv[0] = bf_lo(r0.x); xv[1] = bf_hi(r0.x); xv[2] = bf_lo(r0.y); xv[3] = bf_hi(r0.y); xv[4] = bf_lo(r0.z); xv[5] = bf_hi(r0.z); xv[6] = bf_lo(r0.w); xv[7] = bf_hi(r0.w);
                xv[8] = bf_lo(r1.x); xv[9] = bf_hi(r1.x); xv[10] = bf_lo(r1.y); xv[11] = bf_hi(r1.y); xv[12] = bf_lo(r1.z); xv[13] = bf_hi(r1.z); xv[14] = bf_lo(r1.w); xv[15] = bf_hi(r1.w);
                float sm = 0.f;
#pragma unroll
                for (int e = 0; e < 16; ++e) sm += xv[e];
                sm += __shfl_xor(sm, 1); sm += __shfl_xor(sm, 2);
                const float mu = sm * (1.0f / 64.0f); float q = 0.f;
#pragma unroll
                for (int e = 0; e < 16; ++e) { xv[e] -= mu; q += xv[e] * xv[e]; }
                q += __shfl_xor(q, 1); q += __shfl_xor(q, 2);
                const float rstd = rsqrtf(q * (1.0f / 64.0f) + EPS);
#pragma unroll
                for (int e = 0; e < 16; ++e) { const float y = xv[e] * rstd * lgv[e >> 2][e & 3] + lbv[e >> 2][e & 3]; VLT[(16 * qd + e) * VLP + jt] = (bf16_t)(pk2(y, 0.f) & 0xffffu); }
            }
            const int un = u + ustep;
            if (ui + 1 < ucnt) { const bf16_t* vp = Z + ((size_t)(un >> 3) * 128 + jt) * NZ + 1024 + (un & 7) * 64 + 16 * qd; r0 = *(const u32x4*)vp; r1 = *(const u32x4*)(vp + 8);
#pragma unroll
                for (int e4 = 0; e4 < 4; ++e4) { lgv[e4] = *(const f32x4*)(KA->gm_ln_g + (un & 7) * 64 + 16 * qd + 4 * e4); lbv[e4] = *(const f32x4*)(KA->gm_ln_b + (un & 7) * 64 + 16 * qd + 4 * e4); } }
            const int itok = 32 * iblk + r32;
            const bf16_t* up = Z + (t0 + itok) * NZ + 512 + h * 64 + 32 * dblk + 4 * hi;
            u32x2 uu[4];
#pragma unroll
            for (int g = 0; g < 4; ++g) uu[g] = *(const u32x2*)(up + 8 * g);
            const float bsp = KA->b_spatial[h * 128 + itok];
            bf16x8 wf[8];
            { const bf16_t* wp = WSP + ((size_t)h * 128 + itok) * 128 + 8 * hi;
#pragma unroll
              for (int s = 0; s < 8; ++s) if (s < 4 || iblk >= 2) wf[s] = *(const bf16x8*)(wp + 16 * s); }
            __syncthreads();
            {
                f32x16 acc;
#pragma unroll
                for (int r = 0; r < 16; ++r) acc[r] = 0.f;
                const LAS bf16_t* vl = VLT + (32 * dblk + r32) * VLP + 8 * hi;
#pragma unroll
                for (int s = 0; s < 8; ++s) if (s < 4 || iblk >= 2) {
                    const bf16x8 vf = *(const LAS bf16x8*)(vl + 16 * s);
                    acc = __builtin_amdgcn_mfma_f32_32x32x16_bf16(vf, wf[s], acc, 0, 0, 0);
                }
                bf16_t* op = AO + (t0 + itok) * DM + 512 + h * 64 + 32 * dblk + 4 * hi;
#pragma unroll
                for (int g = 0; g < 4; ++g) {
                    u32x2 w; w.x = pk2(bf_lo(uu[g].x) * (acc[4 * g] + bsp), bf_hi(uu[g].x) * (acc[4 * g + 1] + bsp)); w.y = pk2(bf_lo(uu[g].y) * (acc[4 * g + 2] + bsp), bf_hi(uu[g].y) * (acc[4 * g + 3] + bsp));
                    *(u32x2*)(op + 8 * g) = w;
                }
            }
            __syncthreads();
        }
    }
    }
    }

    { KARGS();
#pragma unroll 1
    for (int rep_ = 0; rep_ < (PROBE == 4 ? 2 : 1); ++rep_) {
    { int Kh = QL; asm volatile("" : "+s"(Kh)); pg8::Gemm g{CQN, WUQ, MTOK, NQ, Kh}; pg8::StaticOrder S; S.init(MTOK, NQ, G, bx); pg8::EpiQ E{Q, ROPE};
      pg8::gemm_phase<pg8::EpiQ, pg8::StaticOrder, true, true>(lds, g, S, E); }
    }
    { KARGS();
    { int Kh = KVL; asm volatile("" : "+s"(Kh)); pg8::Gemm g{CKVN, WUK, MTOK, NKN, Kh}; pg8::StaticOrder S; S.init(MTOK, NKN, G, bx); pg8::EpiBf16 E{KN, NKN, 1 << 30};
      pg8::gemm_phase<pg8::EpiBf16, pg8::StaticOrder, true, true>(lds, g, S, E); }
    }
    { KARGS();
    { int Kh = KVL; asm volatile("" : "+s"(Kh)); pg8::Gemm g{WUV, CKVN, 512, MTOK, Kh}; pg8::StaticOrder S; S.init(512, MTOK, G, bx); pg8::EpiBf16 E{VT, MTOK, 1 << 30};
      pg8::gemm_phase<pg8::EpiBf16, pg8::StaticOrder, true, true>(lds, g, S, E); }
    }
    }
    GSYNC();

    { KARGS();
    attn_phase(lds, Q, KN, KR, VT, AO, vcu, G, tid, lane, wave);
#if PROBE == 2
    __syncthreads();
    attn_phase(lds, Q, KN, KR, VT, AO, vcu, G, tid, lane, wave);
#endif
    }
    GSYNC();

    if (G == 256) {
#pragma unroll 1
        for (int call = 0; call < 2; ++call) { KARGS();
            pg8::Gemm g{AO + (size_t)call * (MTOK / 2) * DM, WO, MTOK / 2, DM, DM}; pg8::StaticOrder S; S.init(MTOK / 2, DM, G, bx);
            pg8::PanelSS st1{(float*)(ws + WS_XB) + 1 * 131072, (unsigned*)(ws + WS_CNT) + 1 * 8192, 64 * call, EPS};
            pg8::PanelSS st2{(float*)(ws + WS_XB) + 2 * 131072, (unsigned*)(ws + WS_CNT) + 2 * 8192, 64 * call, EPS};
            pg8::Unit u0; u0.pm = 0; u0.pn = 0; (void)S.next(0, u0);
            const float* gvb = (const float*)(ws + WS_GV) + (call * 4 + (u0.pm >> 4)) * DM;
            pg8::EpiRmsResRms E2{KA->x, KA->out, XN, gvb, gvb + 8192, gvb + 16384, call * (MTOK / 2), st1, st2};
            pg8::gemm_phase<pg8::EpiRmsResRms, pg8::StaticOrder, false, true>(lds, g, S, E2); }
        GSYNC();
    } else {
    { KARGS();
#pragma unroll 1
    for (int rep_ = 0; rep_ < (PROBE == 8 ? 2 : 1); ++rep_) {
    { pg8::Gemm g{AO, WO, MTOK, DM, DM}; pg8::StaticOrder S; S.init(MTOK, DM, G, bx); pg8::EpiBf16 E{MB, DM, 1 << 30};
      pg8::gemm_phase<pg8::EpiBf16, pg8::StaticOrder, true, true>(lds, g, S, E); }
    }
    }
    GSYNC();

    { KARGS();
#pragma unroll 1
    for (int rep_ = 0; rep_ < (PROBE == 6 ? 2 : 1); ++rep_) {
    for (int r0 = gw * 16; r0 < MTOK; r0 += NGW * 16) {
        const int b = r0 >> 12; const float* ad = ADA + b * 6144;
        f32x4 G1[4], G2[4], S2[4];
#pragma unroll
        for (int j = 0; j < 4; ++j) { const int c = 4 * lane + 256 * j;
            G1[j] = *(const f32x4*)(KA->g_post_mix + c) * *(const f32x4*)(ad + 2048 + c);
            G2[j] = *(const f32x4*)(KA->g_pre_ffn + c) * (1.0f + *(const f32x4*)(ad + 4096 + c));
            S2[j] = *(const f32x4*)(ad + 3072 + c); }
        u32x2 mn[4]; f32x4 xn[4];
#pragma unroll
        for (int j = 0; j < 4; ++j) { mn[j] = *(const u32x2*)(MB + (size_t)r0 * DM + 4 * lane + 256 * j); xn[j] = *(const f32x4*)(KA->x + (size_t)r0 * DM + 4 * lane + 256 * j); }
        for (int rr = 0; rr < 16; ++rr) {
            const size_t row = (size_t)(r0 + rr), nrow = (size_t)(r0 + (rr < 15 ? rr + 1 : 15));
            f32x4 mv[4], xv[4]; float ss = 0.f;
#pragma unroll
            for (int j = 0; j < 4; ++j) { const u32x2 w = mn[j]; mv[j] = (f32x4){bf_lo(w.x), bf_hi(w.x), bf_lo(w.y), bf_hi(w.y)}; xv[j] = xn[j];
                mn[j] = *(const u32x2*)(MB + nrow * DM + 4 * lane + 256 * j); xn[j] = *(const f32x4*)(KA->x + nrow * DM + 4 * lane + 256 * j);
                ss += (mv[j][0] * mv[j][0] + mv[j][1] * mv[j][1]) + (mv[j][2] * mv[j][2] + mv[j][3] * mv[j][3]); }
            const float rs = rsqrtf(wave_sum(ss) * (1.0f / DM) + EPS);
            float s2 = 0.f;
#pragma unroll
            for (int j = 0; j < 4; ++j) { xv[j] = xv[j] + mv[j] * rs * G1[j]; *(f32x4*)(KA->out + row * DM + 4 * lane + 256 * j) = xv[j];
                s2 += (xv[j][0] * xv[j][0] + xv[j][1] * xv[j][1]) + (xv[j][2] * xv[j][2] + xv[j][3] * xv[j][3]); }
            const float r2 = rsqrtf(wave_sum(s2) * (1.0f / DM) + EPS);
#pragma unroll
            for (int j = 0; j < 4; ++j) { const f32x4 o = xv[j] * r2 * G2[j] + S2[j]; u32x2 w; w.x = pk2(o[0], o[1]); w.y = pk2(o[2], o[3]); *(u32x2*)(XN + row * DM + 4 * lane + 256 * j) = w; }
        }
    }
    }
    }
    GSYNC();
    }

    { KARGS();
#pragma unroll 1
    for (int rep_ = 0; rep_ < (PROBE == 9 ? 2 : 1); ++rep_) {
    { pg8::Gemm g{XN, WUP, MTOK, NUP, DM}; pg8::StaticOrder S; S.init(MTOK, NUP, G, bx); pg8::EpiConv E{ACT, SIDE, KA->conv_w, KA->conv_b, (LAS float*)(lds + 131072 + 1024)};
      pg8::gemm_phase<pg8::EpiConv, pg8::StaticOrder, true, true>(lds, g, S, E); }
    }
    }
    GSYNC();

    { KARGS();
    for (int idx = gid; idx < 128 * DFF; idx += NT_ALL) {
        const int pm = idx / DFF, j = idx - pm * DFF;
        if ((pm & 15) == 0) continue;
        const float* sp = SIDE + ((size_t)((pm - 1) * 4 + 2) * 2) * DFF + j;
        const float* sc = SIDE + ((size_t)(pm * 4 + 0) * 2) * DFF + j;
        const float p2a = sp[0], p2b = sp[DFF], p1a = sp[2 * DFF], p1b = sp[3 * DFF], x0a = sc[0], x0b = sc[DFF], x1a = sc[2 * DFF], x1b = sc[3 * DFF];
        const float wa0 = KA->conv_w[j], wa1 = KA->conv_w[NUP + j], wa2 = KA->conv_w[2 * NUP + j], wb0 = KA->conv_w[DFF + j], wb1 = KA->conv_w[NUP + DFF + j], wb2 = KA->conv_w[2 * NUP + DFF + j];
        const float ba = KA->conv_b[j], bb = KA->conv_b[DFF + j];
        const float ya0 = ba + wa0 * p2a + wa1 * p1a + wa2 * x0a, ya1 = ba + wa0 * p1a + wa1 * x0a + wa2 * x1a;
        const float yb0 = bb + wb0 * p2b + wb1 * p1b + wb2 * x0b, yb1 = bb + wb0 * p1b + wb1 * x0b + wb2 * x1b;
        ACT[(size_t)(pm * 256) * DFF + j] = (bf16_t)(pk2(silu_f(ya0) * yb0, 0.f) & 0xffffu);
        ACT[(size_t)(pm * 256 + 1) * DFF + j] = (bf16_t)(pk2(silu_f(ya1) * yb1, 0.f) & 0xffffu);
    }
    }
    GSYNC();

    if (G == 256) {
#pragma unroll 1
        for (int call = 0; call < 2; ++call) { KARGS();
            pg8::Gemm g{ACT + (size_t)call * (MTOK / 2) * DFF, WDN, MTOK / 2, DM, DFF}; pg8::StaticOrder S; S.init(MTOK / 2, DM, G, bx);
            pg8::PanelSS st{(float*)(ws + WS_XB), (unsigned*)(ws + WS_CNT), 64 * call, EPS};
            pg8::Unit u0; u0.pm = 0; u0.pn = 0; (void)S.next(0, u0);
            pg8::EpiRmsRes E2{KA->out, KA->out, (const float*)(ws + WS_GV) + 24576 + (call * 4 + (u0.pm >> 4)) * DM, call * (MTOK / 2), st};
            pg8::gemm_phase<pg8::EpiRmsRes, pg8::StaticOrder, false, true>(lds, g, S, E2); }
    } else {
    { KARGS();
#pragma unroll 1
    for (int rep_ = 0; rep_ < (PROBE == 11 ? 2 : 1); ++rep_) {
    { pg8::Gemm g{ACT, WDN, MTOK, DM, DFF}; pg8::StaticOrder S; S.init(MTOK, DM, G, bx); pg8::EpiBf16 E{FB, DM, 1 << 30};
      pg8::gemm_phase<pg8::EpiBf16, pg8::StaticOrder, true, true>(lds, g, S, E); }
    }
    }
    GSYNC();

    { KARGS();
    for (int r0 = gw * 16; r0 < MTOK; r0 += NGW * 16) {
        const int b = r0 >> 12; const float* ad = ADA + b * 6144;
        f32x4 G3[4];
#pragma unroll
        for (int j = 0; j < 4; ++j) { const int c = 4 * lane + 256 * j; G3[j] = *(const f32x4*)(KA->g_post_ffn + c) * *(const f32x4*)(ad + 5120 + c); }
        u32x2 fn[4]; f32x4 xn[4];
#pragma unroll
        for (int j = 0; j < 4; ++j) { fn[j] = *(const u32x2*)(FB + (size_t)r0 * DM + 4 * lane + 256 * j); xn[j] = *(const f32x4*)(KA->out + (size_t)r0 * DM + 4 * lane + 256 * j); }
        for (int rr = 0; rr < 16; ++rr) {
            const size_t row = (size_t)(r0 + rr); const bool last = (rr == 15); const size_t nrow = (size_t)(r0 + (last ? 15 : rr + 1));
            f32x4 fv[4], x1[4]; float ss = 0.f;
#pragma unroll
            for (int j = 0; j < 4; ++j) { const u32x2 w = fn[j]; fv[j] = (f32x4){bf_lo(w.x), bf_hi(w.x), bf_lo(w.y), bf_hi(w.y)}; x1[j] = xn[j];
                if (!last) { fn[j] = *(const u32x2*)(FB + nrow * DM + 4 * lane + 256 * j); xn[j] = *(const f32x4*)(KA->out + nrow * DM + 4 * lane + 256 * j); }
                ss += (fv[j][0] * fv[j][0] + fv[j][1] * fv[j][1]) + (fv[j][2] * fv[j][2] + fv[j][3] * fv[j][3]); }
            const float rs = rsqrtf(wave_sum(ss) * (1.0f / DM) + EPS);
#pragma unroll
            for (int j = 0; j < 4; ++j) *(f32x4*)(KA->out + row * DM + 4 * lane + 256 * j) = x1[j] + fv[j] * rs * G3[j];
        }
    }
    }
    }
}

#undef tid
#undef lane
#undef wave
#undef G
#undef bx
#undef vcu
#undef gw
#undef NGW
#undef gid
#undef NT_ALL
#undef ws
#undef ADA
#undef ROPE
#undef WSP
#undef WIN
#undef WUQ
#undef WUK
#undef WUV
#undef WO
#undef WUP
#undef WDN
#undef XN
#undef Z
#undef CQN
#undef CKVN
#undef KR
#undef Q
#undef KN
#undef VT
#undef AO
#undef MB
#undef SIDE
#undef ACT
#undef FB
extern "C" void kernel_launch(void* const* d_in, const int* in_sizes, int n_in, void* d_out, int out_size, void* d_ws, size_t ws_size, hipStream_t stream) {
    static int grid = 0;
    if (grid == 0) {
        if (n_in != 22 || ws_size < WS_END) { fprintf(stderr, "kernel_launch: unexpected inputs (n_in %d, ws %zu)\n", n_in, ws_size); grid = -1; return; }
        int dev = 0, cus = 0, per_cu = 0;
        (void)hipGetDevice(&dev); (void)hipDeviceGetAttribute(&cus, hipDeviceAttributeMultiprocessorCount, dev);
        (void)hipFuncSetAttribute((const void*)mega_fwd, hipFuncAttributeMaxDynamicSharedMemorySize, LDS_BYTES);
        if (hipOccupancyMaxActiveBlocksPerMultiprocessor(&per_cu, (const void*)mega_fwd, 512, LDS_BYTES) != hipSuccess || per_cu < 1) per_cu = 1;
        (void)hipGetLastError();
        grid = cus * per_cu; if (grid <= 0) grid = 256;
    }
    if (grid < 0) return;
    (void)hipMemsetAsync((char*)d_ws + WS_ADA, 0, CTL_ZERO_BYTES, stream);
    Args a{};
    const float** ap = (const float**)&a;
    for (int i = 0; i < 22; ++i) ap[i] = (const float*)d_in[i];
    a.out = (float*)d_out; a.ws = (unsigned char*)d_ws;
    void* args[] = {&a};
    hipError_t e = hipLaunchCooperativeKernel((const void*)mega_fwd, dim3(grid), dim3(512), args, LDS_BYTES, stream);
    if (e != hipSuccess) fprintf(stderr, "cooperative launch failed: %s (grid %d)\n", hipGetErrorString(e), grid);
}
```

```cpp
#define PROBE 0
#include <hip/hip_runtime.h>
#include <hip/hip_cooperative_groups.h>
#include <cstdio>
#include <cstdint>
namespace cg = cooperative_groups;
#ifndef PROBE
#define PROBE 0
#endif
#if PROBE == 1
#define GSYNC() do { xcd_barrier(xbar); xcd_barrier(xbar); } while (0)
#else
#define GSYNC() xcd_barrier(xbar)
#endif

#define LAS __attribute__((address_space(3)))
typedef unsigned short bf16_t;
typedef short bf16x8 __attribute__((ext_vector_type(8)));
typedef float f32x4 __attribute__((ext_vector_type(4)));
typedef float f32x16 __attribute__((ext_vector_type(16)));
typedef unsigned u32x4 __attribute__((ext_vector_type(4)));
typedef unsigned u32x2 __attribute__((ext_vector_type(2)));
typedef float f32x2_t __attribute__((ext_vector_type(2)));
typedef __bf16 bf16x2_t __attribute__((ext_vector_type(2)));

__device__ __forceinline__ unsigned pk2(float lo, float hi) { f32x2_t v = {lo, hi}; bf16x2_t b = __builtin_convertvector(v, bf16x2_t); return __builtin_bit_cast(unsigned, b); }
__device__ __forceinline__ float bf_lo(unsigned u) { return __uint_as_float(u << 16); }
__device__ __forceinline__ float bf_hi(unsigned u) { return __uint_as_float(u & 0xffff0000u); }
__device__ __forceinline__ float wave_sum(float v) {
#pragma unroll
    for (int o = 1; o < 64; o <<= 1) v += __shfl_xor(v, o);
    return v;
}
__device__ __forceinline__ float gelu_tanh(float x) {
    const float t = x * (1.0f + 0.044715f * x * x);
    const float e = __builtin_amdgcn_exp2f(-2.0f * 0.7978845608028654f * 1.4426950408889634f * t);
    return x * __builtin_amdgcn_rcpf(1.0f + e);
}
__device__ __forceinline__ float silu_f(float x) { return x * __builtin_amdgcn_rcpf(1.0f + __builtin_amdgcn_exp2f(-1.4426950408889634f * x)); }

constexpr int NB = 8, SEQ = 4096, DM = 1024, MTOK = NB * SEQ;
constexpr int NZ = 1536;
constexpr int QL = 256, KVL = 128, NQ = 768, NKN = 512, DFF = 2816, NUP = 5632;
constexpr float EPS = 1e-6f;
constexpr float C2 = 0.10206207261596575f * 1.4426950408889634f;

constexpr size_t MiB = 1u << 20;
constexpr size_t WS_ADA = 0;
constexpr size_t CTL_ZERO_BYTES = 512 * 1024;
constexpr size_t WS_CNT = 256 * 1024;
constexpr size_t WS_GV = 1 * MiB + 768 * 1024;
constexpr size_t WS_XB = 25 * MiB;
constexpr size_t WS_BAR = 200 * 1024;
constexpr size_t WS_ROPE = 1 * MiB;
constexpr size_t WS_WSP = 1 * MiB + 512 * 1024;
constexpr size_t WS_WIN = 2 * MiB;
constexpr size_t WS_WUQ = 5 * MiB;
constexpr size_t WS_WUK = 5 * MiB + 512 * 1024;
constexpr size_t WS_WUV = 5 * MiB + 768 * 1024;
constexpr size_t WS_WO = 6 * MiB;
constexpr size_t WS_WUP = 8 * MiB;
constexpr size_t WS_WDN = 19 * MiB;
constexpr size_t WS_XN = 32 * MiB;
constexpr size_t WS_Z = 96 * MiB;
constexpr size_t WS_CQN = 192 * MiB;
constexpr size_t WS_CKVN = 208 * MiB;
constexpr size_t WS_KR = 216 * MiB;
constexpr size_t WS_Q = 218 * MiB;
constexpr size_t WS_KN = 266 * MiB;
constexpr size_t WS_VT = 298 * MiB;
constexpr size_t WS_AO = 330 * MiB;
constexpr size_t WS_MB = 394 * MiB;
constexpr size_t WS_SIDE = 96 * MiB;
constexpr size_t WS_ACT = 272 * MiB;
constexpr size_t WS_FB = 448 * MiB;
constexpr size_t WS_END = 512 * MiB;

constexpr int LDS_BYTES = 147456;

struct Args {
    const float* x; const float* c; const float* w_ada; const float* b_ada; const float* g_pre_mix; const float* g_post_mix;
    const float* w_in; const float* g_q; const float* w_uq; const float* g_kv; const float* w_ukv; const float* gm_ln_g; const float* gm_ln_b;
    const float* w_spatial; const float* b_spatial; const float* w_out; const float* g_pre_ffn; const float* g_post_ffn;
    const float* w_up; const float* conv_w; const float* conv_b; const float* w_down;
    float* out; unsigned char* ws;
};

#define CAS __attribute__((address_space(4)))
__device__ __forceinline__ const CAS Args* kargs() { const CAS void* p = (const CAS void*)__builtin_amdgcn_kernarg_segment_ptr(); asm volatile("" : "+s"(p)); return (const CAS Args*)p; }
#define KARGS() const CAS Args* KA = kargs()
__device__ __forceinline__ int otid() { int t = threadIdx.x; asm volatile("" : "+v"(t)); return t; }

namespace pg8 {
#define PG8_LAS __attribute__((address_space(3)))
constexpr int BM = 256, BK = 64, HALF = 128, HTB = HALF * BK * 2, STAGE_BYTES = 8 * HTB, NXCD = 8, WGM = 2;
__host__ __device__ __forceinline__ int lds_byte(int r, int c) { const int st = (r >> 4) * 2 + (c >> 5), rr = r & 15, cc = c & 31, ob = rr * 64 + cc * 2; return st * 1024 + (ob ^ (((ob >> 9) & 1) << 5)); }
__host__ __device__ __forceinline__ void stage_rc(int b, int& R, int& C) { const int st = b / 1024, sb = b % 1024, swz = sb ^ (((sb >> 9) & 1) << 5); R = (st >> 1) * 16 + swz / 64; C = (st & 1) * 32 + (swz % 64) / 2; }
__host__ __device__ __forceinline__ int perm32(int rho) { const int n = rho >> 4, i = rho & 15; return 8 * (i >> 2) + 4 * n + (i & 3); }

__device__ __forceinline__ unsigned cvt_pk_bf16(float lo, float hi) { unsigned r; asm volatile("v_cvt_pk_bf16_f32 %0, %1, %2" : "=v"(r) : "v"(lo), "v"(hi)); return r; }
struct Unit { int pm, pn; };
struct Gemm { const bf16_t* A; const bf16_t* Bt; int M, N, K; };

struct StaticOrder {
    int nM, nN, nwg, G, c;
    __host__ __device__ __forceinline__ void init(int M, int N, int G_, int c_) { nM = M / BM; nN = N / BM; nwg = nM * nN; G = G_; c = c_; }
    __host__ __device__ __forceinline__ bool next(int i, Unit& u) const {
        const long L = (long)i * G + c; if (L >= nwg) return false;
        int wgid = (int)L; { const int q = nwg / NXCD, r = nwg % NXCD, xcd = wgid % NXCD, off = wgid / NXCD; wgid = (xcd < r ? xcd * (q + 1) : r * (q + 1) + (xcd - r) * q) + off; }
        const int nig = WGM * nN, gid = wgid / nig, fm = gid * WGM, gsz = (nM - fm) < WGM ? (nM - fm) : WGM;
        u.pm = fm + ((wgid % nig) % gsz); u.pn = (wgid % nig) / gsz; return true;
    }
    __device__ __forceinline__ void a_ready(const Unit&) const {}
    __device__ __forceinline__ void done(const Unit&) const {}
};

struct EpiBf16 {
    static constexpr bool PERM = true, AFTER_DRAIN = false, NONTRANS = false;
    bf16_t* O; int ldc; int gelu_from;
    __device__ __forceinline__ void operator()(const f32x4 (&acc)[2][2][4][2], const Unit& u, int wr, int wc, int fr, int fq) const {
        const int row0 = u.pm * BM + wr * 64 + fr; const int col0 = u.pn * BM + wc * 32 + 8 * fq;
        const bool act = u.pn >= gelu_from;
#pragma unroll
        for (int ai = 0; ai < 2; ++ai)
#pragma unroll
            for (int m = 0; m < 4; ++m) { bf16_t* rowp = O + (size_t)(row0 + ai * HALF + m * 16) * ldc + col0;
#pragma unroll
                for (int bj = 0; bj < 2; ++bj) { f32x4 v0 = acc[ai][bj][m][0], v1 = acc[ai][bj][m][1];
                    if (act) {
#pragma unroll
                        for (int e = 0; e < 4; ++e) { v0[e] = gelu_tanh(v0[e]); v1[e] = gelu_tanh(v1[e]); } }
                    u32x4 w; w.x = cvt_pk_bf16(v0[0], v0[1]); w.y = cvt_pk_bf16(v0[2], v0[3]); w.z = cvt_pk_bf16(v1[0], v1[1]); w.w = cvt_pk_bf16(v1[2], v1[3]);
                    *(u32x4*)(rowp + bj * HALF) = w; } }
    }
};
struct EpiZ2 {
    static constexpr bool PERM = true, AFTER_DRAIN = false, NONTRANS = false;
    bf16_t* Zo; bf16_t* CQNo; bf16_t* CKVNo; bf16_t* KRo; const float* gq; const float* gkv; const float* rope; PG8_LAS float* P;
    __device__ __forceinline__ void operator()(const f32x4 (&acc)[2][2][4][2], const Unit& u, int wr, int wc, int fr, int fq) const {
        const int row0 = u.pm * BM + wr * 64 + fr;
        if (u.pn >= 2) {
            const int col0 = u.pn * BM + wc * 32 + 8 * fq;
#pragma unroll
            for (int ai = 0; ai < 2; ++ai)
#pragma unroll
                for (int m = 0; m < 4; ++m) { bf16_t* rowp = Zo + (size_t)(row0 + ai * HALF + m * 16) * NZ + col0;
#pragma unroll
                    for (int bj = 0; bj < 2; ++bj) { f32x4 v0 = acc[ai][bj][m][0], v1 = acc[ai][bj][m][1];
#pragma unroll
                        for (int e = 0; e < 4; ++e) { v0[e] = gelu_tanh(v0[e]); v1[e] = gelu_tanh(v1[e]); }
                        u32x4 w; w.x = cvt_pk_bf16(v0[0], v0[1]); w.y = cvt_pk_bf16(v0[2], v0[3]); w.z = cvt_pk_bf16(v1[0], v1[1]); w.w = cvt_pk_bf16(v1[2], v1[3]);
                        *(u32x4*)(rowp + bj * HALF) = w; } }
            return;
        }
        const bool isq = (u.pn == 0);
#pragma unroll
        for (int ai = 0; ai < 2; ++ai)
#pragma unroll
            for (int m = 0; m < 4; ++m) {
                const f32x4 a0 = acc[ai][0][m][0], a1 = acc[ai][0][m][1], b0 = acc[ai][1][m][0], b1 = acc[ai][1][m][1];
                float s = ((a0[0] * a0[0] + a0[1] * a0[1]) + (a0[2] * a0[2] + a0[3] * a0[3])) + ((a1[0] * a1[0] + a1[1] * a1[1]) + (a1[2] * a1[2] + a1[3] * a1[3]));
                if (isq) s += ((b0[0] * b0[0] + b0[1] * b0[1]) + (b0[2] * b0[2] + b0[3] * b0[3])) + ((b1[0] * b1[0] + b1[1] * b1[1]) + (b1[2] * b1[2] + b1[3] * b1[3]));
                s += __shfl_xor(s, 16); s += __shfl_xor(s, 32);
                if (fq == 0) P[(ai * HALF + wr * 64 + m * 16 + fr) * 4 + wc] = s;
            }
        asm volatile("s_waitcnt lgkmcnt(0)" ::: "memory"); __builtin_amdgcn_s_barrier(); asm volatile("" ::: "memory");
        const float invn = isq ? (1.0f / QL) : (1.0f / KVL);
        const int c8 = wc * 32 + 8 * fq;
        const float sgn = (fq < 2) ? -1.0f : 1.0f;
#pragma unroll
        for (int ai = 0; ai < 2; ++ai)
#pragma unroll
            for (int m = 0; m < 4; ++m) {
                const int rl = ai * HALF + wr * 64 + m * 16 + fr; const int row = u.pm * BM + rl;
                const float rs = rsqrtf(((P[rl * 4 + 0] + P[rl * 4 + 1]) + (P[rl * 4 + 2] + P[rl * 4 + 3])) * invn + EPS);
                if (isq) {
#pragma unroll
                    for (int bj = 0; bj < 2; ++bj) { const f32x4 g0 = *(const f32x4*)(gq + bj * HALF + c8), g1 = *(const f32x4*)(gq + bj * HALF + c8 + 4);
                        const f32x4 v0 = acc[ai][bj][m][0] * rs * g0, v1 = acc[ai][bj][m][1] * rs * g1;
                        u32x4 w; w.x = cvt_pk_bf16(v0[0], v0[1]); w.y = cvt_pk_bf16(v0[2], v0[3]); w.z = cvt_pk_bf16(v1[0], v1[1]); w.w = cvt_pk_bf16(v1[2], v1[3]);
                        *(u32x4*)(CQNo + (size_t)row * QL + bj * HALF + c8) = w; }
                } else {
                    { const f32x4 g0 = *(const f32x4*)(gkv + c8), g1 = *(const f32x4*)(gkv + c8 + 4);
                      const f32x4 v0 = acc[ai][0][m][0] * rs * g0, v1 = acc[ai][0][m][1] * rs * g1;
                      u32x4 w; w.x = cvt_pk_bf16(v0[0], v0[1]); w.y = cvt_pk_bf16(v0[2], v0[3]); w.z = cvt_pk_bf16(v1[0], v1[1]); w.w = cvt_pk_bf16(v1[2], v1[3]);
                      *(u32x4*)(CKVNo + (size_t)row * KVL + c8) = w; }
                    if (wc == 0) {
                        f32x4 v0 = acc[ai][1][m][0], v1 = acc[ai][1][m][1];
                        const float* rp = rope + (size_t)(row & (SEQ - 1)) * 32 + 16 * (fq & 1);
                        const f32x4 c0 = *(const f32x4*)rp, c1 = *(const f32x4*)(rp + 4), c2 = *(const f32x4*)(rp + 8), c3 = *(const f32x4*)(rp + 12);
                        const float cs[8] = {c0[0], c0[2], c1[0], c1[2], c2[0], c2[2], c3[0], c3[2]}, sn[8] = {c0[1], c0[3], c1[1], c1[3], c2[1], c2[3], c3[1], c3[3]};
#pragma unroll
                        for (int e = 0; e < 4; ++e) { const float o0 = __shfl_xor(v0[e], 32), o1 = __shfl_xor(v1[e], 32);
                            v0[e] = v0[e] * cs[e] + sgn * o0 * sn[e]; v1[e] = v1[e] * cs[4 + e] + sgn * o1 * sn[4 + e]; }
                        u32x4 w; w.x = cvt_pk_bf16(v0[0], v0[1]); w.y = cvt_pk_bf16(v0[2], v0[3]); w.z = cvt_pk_bf16(v1[0], v1[1]); w.w = cvt_pk_bf16(v1[2], v1[3]);
                        *(u32x4*)(KRo + (size_t)row * 32 + 8 * fq) = w;
                    }
                }
            }
    }
};
struct EpiQ {
    static constexpr bool PERM = true, AFTER_DRAIN = false, NONTRANS = false;
    bf16_t* O; const float* rope;
    __device__ __forceinline__ void operator()(const f32x4 (&acc)[2][2][4][2], const Unit& u, int wr, int wc, int fr, int fq) const {
        const int row0 = u.pm * BM + wr * 64 + fr; const int col0 = u.pn * BM + wc * 32 + 8 * fq;
        const float sgn = (fq < 2) ? -1.0f : 1.0f;
#pragma unroll
        for (int bj = 0; bj < 2; ++bj) {
            const int g32 = 8 * u.pn + 4 * bj + wc; const bool is_rope = (g32 % 3) == 2;
#pragma unroll
            for (int ai = 0; ai < 2; ++ai)
#pragma unroll
                for (int m = 0; m < 4; ++m) {
                    const int row = row0 + ai * HALF + m * 16;
                    f32x4 v0 = acc[ai][bj][m][0] * C2, v1 = acc[ai][bj][m][1] * C2;
                    if (is_rope) {
                        const float* rp = rope + (size_t)(row & (SEQ - 1)) * 32 + 16 * (fq & 1);
                        const f32x4 c0 = *(const f32x4*)rp, c1 = *(const f32x4*)(rp + 4), c2 = *(const f32x4*)(rp + 8), c3 = *(const f32x4*)(rp + 12);
                        const float cs[8] = {c0[0], c0[2], c1[0], c1[2], c2[0], c2[2], c3[0], c3[2]}, sn[8] = {c0[1], c0[3], c1[1], c1[3], c2[1], c2[3], c3[1], c3[3]};
#pragma unroll
                        for (int e = 0; e < 4; ++e) {
                            const float o0 = __shfl_xor(v0[e], 32), o1 = __shfl_xor(v1[e], 32);
                            v0[e] = v0[e] * cs[e] + sgn * o0 * sn[e]; v1[e] = v1[e] * cs[4 + e] + sgn * o1 * sn[4 + e];
                        }
                    }
                    u32x4 w; w.x = cvt_pk_bf16(v0[0], v0[1]); w.y = cvt_pk_bf16(v0[2], v0[3]); w.z = cvt_pk_bf16(v1[0], v1[1]); w.w = cvt_pk_bf16(v1[2], v1[3]);
                    *(u32x4*)(O + (size_t)row * NQ + col0 + bj * HALF) = w;
                }
        }
    }
};

struct EpiConv {
    static constexpr bool PERM = false, AFTER_DRAIN = false, NONTRANS = true;
    bf16_t* ACT; float* SIDE; const float* cw; const float* cb; PG8_LAS float* halo;
    __device__ __forceinline__ void operator()(const f32x4 (&acc)[2][2][4][2], const Unit& u, int wr, int wc, int fr, int fq) const {
        const int lane = threadIdx.x & 63;
        if (fq == 3) {
#pragma unroll
            for (int ai = 0; ai < 2; ++ai)
#pragma unroll
                for (int bj = 0; bj < 2; ++bj)
#pragma unroll
                    for (int n = 0; n < 2; ++n) { PG8_LAS float* hp = halo + (((((ai * 2 + wr) * 4 + wc) * 2 + bj) * 2 + n) * 32) + fr; hp[0] = acc[ai][bj][3][n][2]; hp[16] = acc[ai][bj][3][n][3]; }
        }
        asm volatile("s_waitcnt lgkmcnt(0)" ::: "memory"); __builtin_amdgcn_s_barrier(); asm volatile("" ::: "memory");
        const int j0 = 128 * u.pn + 32 * wc + 2 * fr;
        float wa[2][3], wb[2][3], ba[2], bb[2];
#pragma unroll
        for (int n = 0; n < 2; ++n) {
#pragma unroll
            for (int k = 0; k < 3; ++k) { wa[n][k] = cw[k * NUP + j0 + n]; wb[n][k] = cw[k * NUP + DFF + j0 + n]; }
            ba[n] = cb[j0 + n]; bb[n] = cb[DFF + j0 + n]; }
        const int src = ((lane - 16) & 63) * 4;
#pragma unroll
        for (int ai = 0; ai < 2; ++ai) {
            const int blk = 2 * ai + wr;
#pragma unroll
            for (int m = 0; m < 4; ++m) {
                float o[2][4];
#pragma unroll
                for (int n = 0; n < 2; ++n) {
                    const f32x4 Xa = acc[ai][0][m][n], Xb = acc[ai][1][m][n];
                    float da2, da3, db2, db3;
                    if (m > 0) { const bool t = (fq == 3); da2 = t ? acc[ai][0][m > 0 ? m - 1 : 0][n][2] : Xa[2]; da3 = t ? acc[ai][0][m > 0 ? m - 1 : 0][n][3] : Xa[3];
                                 db2 = t ? acc[ai][1][m > 0 ? m - 1 : 0][n][2] : Xb[2]; db3 = t ? acc[ai][1][m > 0 ? m - 1 : 0][n][3] : Xb[3]; }
                    else { da2 = Xa[2]; da3 = Xa[3]; db2 = Xb[2]; db3 = Xb[3]; }
                    float Ha2 = __builtin_bit_cast(float, __builtin_amdgcn_ds_bpermute(src, __builtin_bit_cast(int, da2)));
                    float Ha3 = __builtin_bit_cast(float, __builtin_amdgcn_ds_bpermute(src, __builtin_bit_cast(int, da3)));
                    float Hb2 = __builtin_bit_cast(float, __builtin_amdgcn_ds_bpermute(src, __builtin_bit_cast(int, db2)));
                    float Hb3 = __builtin_bit_cast(float, __builtin_amdgcn_ds_bpermute(src, __builtin_bit_cast(int, db3)));
                    if (m == 0) {
                        float h2a = 0.f, h3a = 0.f, h2b = 0.f, h3b = 0.f;
                        if (blk > 0) { const PG8_LAS float* hp = halo + ((((blk - 1) * 4 + wc) * 2 + 0) * 2 + n) * 32 + fr; h2a = hp[0]; h3a = hp[16]; h2b = hp[64]; h3b = hp[80]; }
                        if (fq == 0) { Ha2 = h2a; Ha3 = h3a; Hb2 = h2b; Hb3 = h3b; }
                    }
                    const f32x2_t W0 = {wa[n][0], wb[n][0]}, W1 = {wa[n][1], wb[n][1]}, W2 = {wa[n][2], wb[n][2]}, B2 = {ba[n], bb[n]};
                    const f32x2_t H2 = {Ha2, Hb2}, H3 = {Ha3, Hb3}, X0 = {Xa[0], Xb[0]}, X1 = {Xa[1], Xb[1]}, X2 = {Xa[2], Xb[2]}, X3 = {Xa[3], Xb[3]};
                    const f32x2_t y0 = B2 + W0 * H2 + W1 * H3 + W2 * X0, y1 = B2 + W0 * H3 + W1 * X0 + W2 * X1, y2 = B2 + W0 * X0 + W1 * X1 + W2 * X2, y3 = B2 + W0 * X1 + W1 * X2 + W2 * X3;
                    const float ya0 = y0[0], yb0 = y0[1], ya1 = y1[0], yb1 = y1[1], ya2 = y2[0], yb2 = y2[1], ya3 = y3[0], yb3 = y3[1];
                    o[n][0] = silu_f(ya0) * yb0; o[n][1] = silu_f(ya1) * yb1; o[n][2] = silu_f(ya2) * yb2; o[n][3] = silu_f(ya3) * yb3;
                    if (blk == 0 && m == 0 && fq == 0) { float* sp = SIDE + ((size_t)(u.pm * 4 + 0) * 2) * DFF + j0 + n; sp[0] = Xa[0]; sp[DFF] = Xb[0]; sp[2 * DFF] = Xa[1]; sp[3 * DFF] = Xb[1]; }
                    if (blk == 3 && m == 3 && fq == 3) { float* sp = SIDE + ((size_t)(u.pm * 4 + 2) * 2) * DFF + j0 + n; sp[0] = Xa[2]; sp[DFF] = Xb[2]; sp[2 * DFF] = Xa[3]; sp[3 * DFF] = Xb[3]; }
                }
                bf16_t* op = ACT + (size_t)(u.pm * BM + ai * HALF + wr * 64 + m * 16 + 4 * fq) * DFF + j0;
#pragma unroll
                for (int e = 0; e < 4; ++e) *(unsigned*)(op + (size_t)e * DFF) = cvt_pk_bf16(o[0][e], o[1][e]);
            }
        }
    }
};

struct PanelSS {
    float* xbuf; unsigned* cnt; int pm_off; float eps;
    __device__ __forceinline__ void run(const f32x4 (&v)[2][2][4][2], const Unit& u, int wr, int wc, int fr, int fq, PG8_LAS unsigned char* lds, int wid, int lane) const {
        PG8_LAS float* P = (PG8_LAS float*)lds; PG8_LAS float* S = (PG8_LAS float*)(lds + 4096);
        const int pmg = u.pm + pm_off;
#pragma unroll
        for (int ai = 0; ai < 2; ++ai)
#pragma unroll
            for (int m = 0; m < 4; ++m) {
                float s = 0.f;
#pragma unroll
                for (int bj = 0; bj < 2; ++bj)
#pragma unroll
                    for (int n = 0; n < 2; ++n) { const f32x4 x = v[ai][bj][m][n]; s += (x[0] * x[0] + x[1] * x[1]) + (x[2] * x[2] + x[3] * x[3]); }
                s += __shfl_xor(s, 16); s += __shfl_xor(s, 32);
                if (fq == 0) P[(ai * HALF + wr * 64 + m * 16 + fr) * 4 + wc] = s;
            }
        asm volatile("s_waitcnt lgkmcnt(0)" ::: "memory"); __builtin_amdgcn_s_barrier(); asm volatile("" ::: "memory");
        const int row = wid * 32 + (lane & 31);
        if (lane < 32) {
            const float tot = (P[row * 4 + 0] + P[row * 4 + 1]) + (P[row * 4 + 2] + P[row * 4 + 3]);
            __hip_atomic_store(xbuf + ((size_t)(pmg * BM + row) * 4 + u.pn), tot, __ATOMIC_RELAXED, __HIP_MEMORY_SCOPE_AGENT);
        }
        asm volatile("s_waitcnt vmcnt(0)" ::: "memory");
        if (lane == 0) __hip_atomic_fetch_add(cnt + 64 * pmg, 1u, __ATOMIC_RELAXED, __HIP_MEMORY_SCOPE_AGENT);
        if (wid == 0) {
            unsigned sp = 0;
            while ((unsigned)__builtin_amdgcn_readfirstlane(__hip_atomic_load(cnt + 64 * pmg, __ATOMIC_RELAXED, __HIP_MEMORY_SCOPE_AGENT)) < 32u) { __builtin_amdgcn_s_sleep(2); if (++sp > (1u << 22)) break; }
            __builtin_amdgcn_fence(__ATOMIC_ACQUIRE, "agent");
        }
        asm volatile("s_waitcnt vmcnt(0) lgkmcnt(0)" ::: "memory"); __builtin_amdgcn_s_barrier(); asm volatile("" ::: "memory");
        if (lane < 32) {
            const float* slot = xbuf + (size_t)(pmg * BM + row) * 4; float t = 0.f;
#pragma unroll
            for (int k = 0; k < 4; ++k) t += __hip_atomic_load(slot + k, __ATOMIC_RELAXED, __HIP_MEMORY_SCOPE_AGENT);
            S[row] = rsqrtf(t * (1.0f / 1024.0f) + eps);
        }
        asm volatile("s_waitcnt lgkmcnt(0)" ::: "memory"); __builtin_amdgcn_s_barrier(); asm volatile("" ::: "memory");
    }
};
struct EpiRmsRes {
    static constexpr bool PERM = false, AFTER_DRAIN = true, NONTRANS = false;
    const float* base; float* out; const float* gv; int row_off; PanelSS st;
    __device__ __forceinline__ void fused(f32x4 (&acc)[2][2][4][2], const Unit& u, int wr, int wc, int fr, int fq, PG8_LAS unsigned char* lds, int wid, int lane) const {
        const PG8_LAS float* S = (const PG8_LAS float*)(lds + 4096);
        const int col0 = u.pn * BM + wc * 32 + 4 * fq;
        st.run(acc, u, wr, wc, fr, fq, lds, wid, lane);
        f32x4 g[2][2];
#pragma unroll
        for (int bj = 0; bj < 2; ++bj)
#pragma unroll
            for (int n = 0; n < 2; ++n) g[bj][n] = *(const f32x4*)(gv + col0 + bj * HALF + n * 16);
#pragma unroll
        for (int ai = 0; ai < 2; ++ai)
#pragma unroll
            for (int m = 0; m < 4; ++m) { const int r = ai * HALF + wr * 64 + m * 16 + fr; const float rs = S[r]; const size_t off = (size_t)(row_off + u.pm * BM + r) * DM + col0;
#pragma unroll
                for (int bj = 0; bj < 2; ++bj)
#pragma unroll
                    for (int n = 0; n < 2; ++n) { const f32x4 bs = *(const f32x4*)(base + off + bj * HALF + n * 16); __builtin_nontemporal_store(bs + acc[ai][bj][m][n] * rs * g[bj][n], (f32x4*)(out + off + bj * HALF + n * 16)); }
                if (m & 1) asm volatile("" ::: "memory"); }
        asm volatile("s_waitcnt lgkmcnt(0)" ::: "memory"); __builtin_amdgcn_s_barrier(); asm volatile("" ::: "memory");
    }
};

struct EpiRmsResRms {
    static constexpr bool PERM = false, AFTER_DRAIN = true, NONTRANS = false;
    const float* base; float* out; bf16_t* xn; const float* gv1; const float* gv2; const float* sv2; int row_off; PanelSS st1, st2;
    __device__ __forceinline__ void fused(f32x4 (&acc)[2][2][4][2], const Unit& u, int wr, int wc, int fr, int fq, PG8_LAS unsigned char* lds, int wid, int lane) const {
        const PG8_LAS float* S = (const PG8_LAS float*)(lds + 4096);
        const int col0 = u.pn * BM + wc * 32 + 4 * fq;
        st1.run(acc, u, wr, wc, fr, fq, lds, wid, lane);
        {
            f32x4 g[2][2];
#pragma unroll
            for (int bj = 0; bj < 2; ++bj)
#pragma unroll
                for (int n = 0; n < 2; ++n) g[bj][n] = *(const f32x4*)(gv1 + col0 + bj * HALF + n * 16);
#pragma unroll
            for (int ai = 0; ai < 2; ++ai)
#pragma unroll
                for (int m = 0; m < 4; ++m) { const int r = ai * HALF + wr * 64 + m * 16 + fr; const float rs = S[r]; const size_t off = (size_t)(row_off + u.pm * BM + r) * DM + col0;
#pragma unroll
                    for (int bj = 0; bj < 2; ++bj)
#pragma unroll
                        for (int n = 0; n < 2; ++n) { const f32x4 bs = __builtin_nontemporal_load((const f32x4*)(base + off + bj * HALF + n * 16)); acc[ai][bj][m][n] = bs + acc[ai][bj][m][n] * rs * g[bj][n]; }
                    asm volatile("" : "+v"(acc[ai][0][m][0]), "+v"(acc[ai][0][m][1]), "+v"(acc[ai][1][m][0]), "+v"(acc[ai][1][m][1]));
                    if (m & 1) asm volatile("" ::: "memory"); }
        }
        st2.run(acc, u, wr, wc, fr, fq, lds, wid, lane);
        {
            f32x4 g[2][2], sv[2][2];
#pragma unroll
            for (int bj = 0; bj < 2; ++bj)
#pragma unroll
                for (int n = 0; n < 2; ++n) { g[bj][n] = *(const f32x4*)(gv2 + col0 + bj * HALF + n * 16); sv[bj][n] = *(const f32x4*)(sv2 + col0 + bj * HALF + n * 16); }
#pragma unroll
            for (int ai = 0; ai < 2; ++ai)
#pragma unroll
                for (int m = 0; m < 4; ++m) { const int r = ai * HALF + wr * 64 + m * 16 + fr; const float rs = S[r]; const size_t off = (size_t)(row_off + u.pm * BM + r) * DM + col0;
#pragma unroll
                    for (int bj = 0; bj < 2; ++bj)
#pragma unroll
                        for (int n = 0; n < 2; ++n) { const f32x4 x1 = acc[ai][bj][m][n]; *(f32x4*)(out + off + bj * HALF + n * 16) = x1;
                            const f32x4 o = x1 * rs * g[bj][n] + sv[bj][n]; u32x2 w; w.x = cvt_pk_bf16(o[0], o[1]); w.y = cvt_pk_bf16(o[2], o[3]); *(u32x2*)(xn + off + bj * HALF + n * 16) = w; }
                    asm volatile("" ::: "memory"); }
        }
        asm volatile("s_waitcnt lgkmcnt(0)" ::: "memory"); __builtin_amdgcn_s_barrier(); asm volatile("" ::: "memory");
    }
};

template <class Epi, class Sched, bool ALIGN_EPI = false, bool SP2 = false>
__device__ __forceinline__ void gemm_phase(PG8_LAS unsigned char* lds, const Gemm g, const Sched& S, const Epi& E) {
    int tid_ = threadIdx.x; asm volatile("" : "+v"(tid_));
    const int tid = tid_, wid = __builtin_amdgcn_readfirstlane(tid >> 6), lane = tid & 63, wr = wid >> 2, wc = wid & 3, fr = lane & 15, fq = lane >> 4;
    const int K = g.K, nt = K / BK;
    unsigned voffA[2], voffB[2];
#pragma unroll
    for (int i = 0; i < 2; ++i) { int R, C; stage_rc(tid * 16 + i * 8192, R, C); const int Rb = Epi::PERM ? ((R & ~31) + perm32(R & 31)) : R;
        voffA[i] = (unsigned)(R * K + C) * 2u; voffB[i] = (unsigned)(Rb * K + C) * 2u; }
    const size_t kstep = (size_t)(BK * 2);
    const size_t hstep = (size_t)HALF * K * 2;
    const size_t tstep = 2 * hstep;
    const unsigned ldsw = (unsigned)wid * 1024u;
    const int aoff = lds_byte(wr * 64 + fr, fq * 8), boff = lds_byte(wc * 32 + fr, fq * 8);
#define PG8_SA(b, h) (((b) * 2 + (h)) * HTB)
#define PG8_SB(b, h) ((4 + (b) * 2 + (h)) * HTB)
#define PG8_STAGE(bufoff, gbase, voff) do { _Pragma("unroll") for (int _i = 0; _i < 2; ++_i) \
        __builtin_amdgcn_global_load_lds((const unsigned*)((const char*)(gbase) + (voff)[_i]), (PG8_LAS unsigned*)(lds + (bufoff) + ldsw + _i * 8192), 16, 0, 0); } while (0)
#define PG8_LDA(dst, b, h) do { _Pragma("unroll") for (int m = 0; m < 4; ++m) _Pragma("unroll") for (int k = 0; k < 2; ++k) dst[m][k] = *(const PG8_LAS bf16x8*)(lds + PG8_SA(b, h) + aoff + m * 2048 + k * 1024); } while (0)
#define PG8_LDB(dst, b, h) do { _Pragma("unroll") for (int n = 0; n < 2; ++n) _Pragma("unroll") for (int k = 0; k < 2; ++k) dst[n][k] = *(const PG8_LAS bf16x8*)(lds + PG8_SB(b, h) + boff + n * 2048 + k * 1024); } while (0)
#define PG8_MMA(ai, bj, At, Bt) do { __builtin_amdgcn_s_setprio(1); _Pragma("unroll") for (int m = 0; m < 4; ++m) _Pragma("unroll") for (int n = 0; n < 2; ++n) _Pragma("unroll") for (int k = 0; k < 2; ++k) \
        acc[ai][bj][m][n] = Epi::NONTRANS ? __builtin_amdgcn_mfma_f32_16x16x32_bf16(At[m][k], Bt[n][k], acc[ai][bj][m][n], 0, 0, 0) : __builtin_amdgcn_mfma_f32_16x16x32_bf16(Bt[n][k], At[m][k], acc[ai][bj][m][n], 0, 0, 0); __builtin_amdgcn_s_setprio(0); } while (0)
#define PG8_WAIT_V(n) asm volatile("s_waitcnt vmcnt(" #n ")" ::: "memory")
#define PG8_WAIT_L(n) asm volatile("s_waitcnt lgkmcnt(" #n ")" ::: "memory")
#define PG8_BAR __builtin_amdgcn_s_barrier()
#define PG8_SCHED __builtin_amdgcn_sched_barrier(0)
    Unit cur, nxt; int ui = 0;
    if (!S.next(0, cur)) return;
    f32x4 acc[2][2][4][2];
#pragma unroll
    for (int a = 0; a < 2; ++a)
#pragma unroll
        for (int b = 0; b < 2; ++b)
#pragma unroll
            for (int m = 0; m < 4; ++m)
#pragma unroll
                for (int n = 0; n < 2; ++n) acc[a][b][m][n] = (f32x4){0.f, 0.f, 0.f, 0.f};
    bf16x8 At[4][2], B0[2][2], B1[2][2];
    const char* cA = (const char*)g.A + (size_t)cur.pm * tstep; const char* cB = (const char*)g.Bt + (size_t)cur.pn * tstep;
    S.a_ready(cur);
    if constexpr (SP2) {
        PG8_STAGE(PG8_SB(0, 0), cB, voffB); PG8_STAGE(PG8_SB(0, 1), cB + hstep, voffB); PG8_STAGE(PG8_SA(0, 0), cA, voffA); PG8_STAGE(PG8_SA(0, 1), cA + hstep, voffA);
        if (wr == 1) PG8_BAR;
        PG8_WAIT_V(2); PG8_BAR;
        PG8_STAGE(PG8_SB(1, 0), cB + kstep, voffB); PG8_STAGE(PG8_SA(1, 0), cA + kstep, voffA); PG8_STAGE(PG8_SB(1, 1), cB + hstep + kstep, voffB);
        PG8_WAIT_V(6); PG8_BAR;
    } else {
        PG8_STAGE(PG8_SB(0, 0), cB, voffB); PG8_STAGE(PG8_SA(0, 0), cA, voffA); PG8_STAGE(PG8_SB(0, 1), cB + hstep, voffB); PG8_STAGE(PG8_SA(0, 1), cA + hstep, voffA);
        if (wr == 1) PG8_BAR;
        PG8_WAIT_V(4); PG8_BAR;
        PG8_STAGE(PG8_SB(1, 0), cB + kstep, voffB); PG8_STAGE(PG8_SA(1, 0), cA + kstep, voffA); PG8_STAGE(PG8_SB(1, 1), cB + hstep + kstep, voffB);
        PG8_WAIT_V(6); PG8_BAR;
    }
    for (;;) {
        const bool has_next = S.next(ui + 1, nxt);
        const char* nA = has_next ? (const char*)g.A + (size_t)nxt.pm * tstep : cA; const char* nB = has_next ? (const char*)g.Bt + (size_t)nxt.pn * tstep : cB;
        for (int t = 0; t < nt; t += 2) {
            const bool last = (t == nt - 2);
            const char* a1 = cA + (size_t)(t + 1) * kstep;
            const char* a2 = last ? nA : cA + (size_t)(t + 2) * kstep; const char* b2 = last ? nB : cB + (size_t)(t + 2) * kstep;
            const char* a3 = a2 + kstep; const char* b3 = b2 + kstep;
            if (last && has_next) S.a_ready(nxt);
            if constexpr (SP2) {
            PG8_LDB(B0, 0, 0); PG8_LDB(B1, 0, 1); PG8_SCHED; PG8_LDA(At, 0, 0); PG8_STAGE(PG8_SA(1, 1), a1 + hstep, voffA);
            PG8_WAIT_V(8); PG8_WAIT_L(0); PG8_BAR; PG8_MMA(0, 0, At, B0); PG8_MMA(0, 1, At, B1); PG8_BAR; PG8_SCHED;
            PG8_LDA(At, 0, 1); PG8_STAGE(PG8_SB(0, 0), b2, voffB); PG8_STAGE(PG8_SB(0, 1), b2 + hstep, voffB); PG8_STAGE(PG8_SA(0, 0), a2, voffA);
            PG8_WAIT_V(8); PG8_WAIT_L(0); PG8_BAR; PG8_MMA(1, 0, At, B0); PG8_MMA(1, 1, At, B1); PG8_BAR; PG8_SCHED;
            PG8_LDB(B0, 1, 0); PG8_LDB(B1, 1, 1); PG8_SCHED; PG8_LDA(At, 1, 0); PG8_STAGE(PG8_SA(0, 1), a2 + hstep, voffA);
            PG8_WAIT_V(8); PG8_WAIT_L(0); PG8_BAR; PG8_MMA(0, 0, At, B0); PG8_MMA(0, 1, At, B1); PG8_BAR; PG8_SCHED;
            PG8_LDA(At, 1, 1); PG8_STAGE(PG8_SB(1, 0), b3, voffB); PG8_STAGE(PG8_SB(1, 1), b3 + hstep, voffB); PG8_STAGE(PG8_SA(1, 0), a3, voffA);
            PG8_WAIT_V(8); PG8_WAIT_L(0); PG8_BAR; PG8_MMA(1, 0, At, B0); PG8_MMA(1, 1, At, B1); PG8_BAR; PG8_SCHED;
            } else {
            PG8_LDB(B0, 0, 0); PG8_SCHED; PG8_LDA(At, 0, 0); PG8_STAGE(PG8_SA(1, 1), a1 + hstep, voffA);
            PG8_WAIT_L(8); PG8_BAR; PG8_WAIT_L(0); PG8_MMA(0, 0, At, B0); PG8_BAR; PG8_SCHED;
            PG8_LDB(B1, 0, 1); PG8_STAGE(PG8_SB(0, 0), b2, voffB);
            PG8_BAR; PG8_WAIT_L(0); PG8_MMA(0, 1, At, B1); PG8_BAR;
            PG8_LDA(At, 0, 1); PG8_STAGE(PG8_SA(0, 0), a2, voffA);
            PG8_BAR; PG8_WAIT_L(0); PG8_MMA(1, 0, At, B0); PG8_BAR; PG8_SCHED;
            PG8_STAGE(PG8_SB(0, 1), b2 + hstep, voffB);
            PG8_WAIT_V(6); PG8_BAR; PG8_MMA(1, 1, At, B1); PG8_BAR;
            PG8_LDB(B0, 1, 0); PG8_SCHED; PG8_LDA(At, 1, 0); PG8_STAGE(PG8_SA(0, 1), a2 + hstep, voffA);
            PG8_WAIT_L(8); PG8_BAR; PG8_WAIT_L(0); PG8_MMA(0, 0, At, B0); PG8_BAR; PG8_SCHED;
            PG8_LDB(B1, 1, 1); PG8_STAGE(PG8_SB(1, 0), b3, voffB);
            PG8_BAR; PG8_WAIT_L(0); PG8_MMA(0, 1, At, B1); PG8_BAR;
            PG8_LDA(At, 1, 1); PG8_STAGE(PG8_SA(1, 0), a3, voffA);
            PG8_BAR; PG8_WAIT_L(0); PG8_MMA(1, 0, At, B0); PG8_BAR; PG8_SCHED;
            PG8_STAGE(PG8_SB(1, 1), b3 + hstep, voffB);
            PG8_WAIT_V(6); PG8_BAR; PG8_MMA(1, 1, At, B1); PG8_BAR;
            }
        }
        if constexpr (ALIGN_EPI) { if (wr == 0) PG8_BAR; }
        if constexpr (!Epi::AFTER_DRAIN) { E(acc, cur, wr, wc, fr, fq); S.done(cur); }
        if (!has_next) break;
#pragma unroll
        for (int a = 0; a < 2; ++a)
#pragma unroll
            for (int b = 0; b < 2; ++b)
#pragma unroll
                for (int m = 0; m < 4; ++m)
#pragma unroll
                    for (int n = 0; n < 2; ++n) acc[a][b][m][n] = (f32x4){0.f, 0.f, 0.f, 0.f};
        cur = nxt; cA = nA; cB = nB; ++ui;
        if constexpr (ALIGN_EPI) { if (wr == 1) PG8_BAR; }
    }
    PG8_WAIT_V(0);
    if constexpr (!ALIGN_EPI) { if (wr == 0) PG8_BAR; }
    PG8_BAR;
    if constexpr (Epi::AFTER_DRAIN) { E.fused(acc, cur, wr, wc, fr, fq, lds, wid, lane); S.done(cur); }
#undef PG8_SA
#undef PG8_SB
#undef PG8_STAGE
#undef PG8_LDA
#undef PG8_LDB
#undef PG8_MMA
#undef PG8_WAIT_V
#undef PG8_WAIT_L
#undef PG8_BAR
#undef PG8_SCHED
}
}
#define XB_TMO      128
#define XB_XCNT(j)  (256  + 64 * (j))
#define XB_XSUB(j)  (1280 + 64 * (j))
#define XB_XGEN(j)  (2304 + 64 * (j))
#define XB_TOP      3328
#define XB_TOPGEN   3392
#define XCD_BAR_WORDS 3456
#define XB_SPIN_CAP (1u << 18)

__device__ __forceinline__ unsigned xb_ld(unsigned* p)              { return __hip_atomic_load(p, __ATOMIC_RELAXED, __HIP_MEMORY_SCOPE_AGENT); }
__device__ __forceinline__ unsigned xb_add(unsigned* p, unsigned v) { return __hip_atomic_fetch_add(p, v, __ATOMIC_RELAXED, __HIP_MEMORY_SCOPE_AGENT); }
__device__ __forceinline__ unsigned xb_xcc_id() { return (unsigned)__builtin_amdgcn_s_getreg((3 << 11) | 20) & 0xFu; }
#define XB_SPIN(cond, bar) do { unsigned _sp = 0; while (cond) { __builtin_amdgcn_s_sleep(1); \
    if ((++_sp & 255u) == 0u) { if (xb_ld(&(bar)[XB_TMO])) break; if (_sp > XB_SPIN_CAP) { atomicAdd(&(bar)[XB_TMO], 1u); break; } } } } while (0)

struct XcdBarrier {
    unsigned* bar; unsigned x;
    volatile LAS unsigned* st;
};

__device__ __forceinline__ XcdBarrier xcd_barrier_post(unsigned* bar, volatile LAS unsigned* st) {
    XcdBarrier b; b.bar = bar; b.x = xb_xcc_id(); b.st = st;
    if (threadIdx.x == 0) (void)xb_add(&bar[XB_XCNT(b.x)], 1u);
    return b;
}
__device__ __forceinline__ void xcd_barrier_complete(unsigned* bar, unsigned x, unsigned& nloc, unsigned& nx) {
    const unsigned G = gridDim.x * gridDim.y * gridDim.z;
    unsigned sum, cnt, mine, sp = 0u;
    for (;;) {
        sum = 0u; cnt = 0u; mine = 0u;
#pragma unroll 1
        for (unsigned j = 0; j < 16; ++j) { const unsigned c = xb_ld(&bar[XB_XCNT(j)]); sum += c; cnt += (c > 0u) ? 1u : 0u; mine = (j == x) ? c : mine; }
        if (sum == G) break;
        __builtin_amdgcn_s_sleep(1);
        if ((++sp & 255u) == 0u) { if (xb_ld(&bar[XB_TMO])) break; if (sp > XB_SPIN_CAP) { atomicAdd(&bar[XB_TMO], 1u); break; } }
    }
    nloc = mine > 0u ? mine : 1u; nx = cnt > 0u ? cnt : 1u;
}

__device__ __forceinline__ void xcd_barrier(const XcdBarrier& b) {
    asm volatile("s_waitcnt vmcnt(0)" ::: "memory");
    __syncthreads();
    if (threadIdx.x == 0) {
        unsigned* bar = b.bar;
        __builtin_amdgcn_s_waitcnt(0);
        unsigned nloc = b.st[0], nx = b.st[1];
        if (nloc == 0u) { xcd_barrier_complete(bar, b.x, nloc, nx); b.st[0] = nloc; b.st[1] = nx; }
        const unsigned old = xb_add(&bar[XB_XSUB(b.x)], 1u);
        const unsigned gen = old / nloc;
        if (old + 1u == (gen + 1u) * nloc) {
            __builtin_amdgcn_fence(__ATOMIC_RELEASE, "agent");
            asm volatile("s_waitcnt vmcnt(0)" ::: "memory");
            const unsigned og = xb_add(&bar[XB_TOP], 1u);
            const unsigned tg = og / nx;
            if (og + 1u == (tg + 1u) * nx) xb_add(&bar[XB_TOPGEN], 1u);
            else XB_SPIN(xb_ld(&bar[XB_TOPGEN]) == tg, bar);
            __builtin_amdgcn_fence(__ATOMIC_ACQUIRE, "agent");
            xb_add(&bar[XB_XGEN(b.x)], 1u);
            asm volatile("s_waitcnt vmcnt(0)" ::: "memory");
        } else {
            XB_SPIN(xb_ld(&bar[XB_XGEN(b.x)]) == gen, bar);
            __builtin_amdgcn_fence(__ATOMIC_ACQUIRE, "agent");
            asm volatile("s_waitcnt vmcnt(0)" ::: "memory");
        }
    }
    __syncthreads();
}

__device__ __forceinline__ void tr_item(const float* __restrict__ W, int K, int N, bf16_t* WT, int k0, int n0, int drow0, LAS float* scr, int lane, bool perm = false) {
    { f32x4 v[8];
#pragma unroll
      for (int i = 0; i < 8; ++i) { const int ch = i * 64 + lane, kk = ch >> 3, c4 = ch & 7; v[i] = __builtin_nontemporal_load((const f32x4*)(W + (size_t)(k0 + kk) * N + n0 + 4 * c4)); }
#pragma unroll
      for (int i = 0; i < 8; ++i) { const int ch = i * 64 + lane, kk = ch >> 3, c4 = ch & 7; LAS float* d = scr + kk * 33 + 4 * c4; d[0] = v[i][0]; d[1] = v[i][1]; d[2] = v[i][2]; d[3] = v[i][3]; } }
    asm volatile("s_waitcnt lgkmcnt(0)" ::: "memory");
    const int c = lane & 7;
#pragma unroll
    for (int j = 0; j < 4; ++j) { const int n = (lane >> 3) + 8 * j; const LAS float* s = scr + (8 * c) * 33 + n;
        u32x4 o; o.x = pk2(s[0 * 33], s[1 * 33]); o.y = pk2(s[2 * 33], s[3 * 33]); o.z = pk2(s[4 * 33], s[5 * 33]); o.w = pk2(s[6 * 33], s[7 * 33]);
        *(u32x4*)(WT + (size_t)(drow0 + (perm ? 16 * (n & 1) + (n >> 1) : n)) * K + k0 + 8 * c) = o; }
    asm volatile("s_waitcnt lgkmcnt(0)" ::: "memory");
}

typedef float f32x2v __attribute__((ext_vector_type(2)));
__device__ __forceinline__ float max3f(float a, float b, float c) { return fmaxf(fmaxf(a, b), c); }
__device__ __forceinline__ void attn_ldk(bf16x8 (&kf)[12], const LAS unsigned char* kb) {
    constexpr int KP = 104;
#pragma unroll
    for (int ks = 0; ks < 6; ++ks) { kf[2 * ks] = *(const LAS bf16x8*)(kb + 32 * ks); kf[2 * ks + 1] = *(const LAS bf16x8*)(kb + 32 * KP * 2 + 32 * ks); }
}
__device__ __forceinline__ void attn_ldv(bf16x8 (&vf)[8], const LAS unsigned char* vb) {
    constexpr int VP = 136;
#pragma unroll
    for (int s = 0; s < 4; ++s) { vf[2 * s] = *(const LAS bf16x8*)(vb + 32 * s); vf[2 * s + 1] = *(const LAS bf16x8*)(vb + 32 * VP * 2 + 32 * s); }
}
__device__ __forceinline__ void attn_qk(f32x16& p0, f32x16& p1, const bf16x8 (&kf)[12], const bf16x8 (&qf)[6]) {
    const f32x16 zero = {0.f, 0.f, 0.f, 0.f, 0.f, 0.f, 0.f, 0.f, 0.f, 0.f, 0.f, 0.f, 0.f, 0.f, 0.f, 0.f};
#pragma unroll
    for (int ks = 0; ks < 6; ++ks) {
        p0 = __builtin_amdgcn_mfma_f32_32x32x16_bf16(kf[2 * ks], qf[ks], ks == 0 ? zero : p0, 0, 0, 0);
        p1 = __builtin_amdgcn_mfma_f32_32x32x16_bf16(kf[2 * ks + 1], qf[ks], ks == 0 ? zero : p1, 0, 0, 0);
    }
}
__device__ __forceinline__ void attn_softmax(f32x16& p0, f32x16& p1, bf16x8 (&pb)[4], f32x16& o0, f32x16& o1, float& m_run, float& l_run) {
    float mx = max3f(p0[0], p0[1], p1[0]), my = max3f(p0[2], p0[3], p1[1]);
    mx = max3f(mx, p1[2], p1[3]);
#pragma unroll
    for (int r = 4; r < 16; r += 4) { mx = max3f(mx, p0[r], p0[r + 1]); my = max3f(my, p0[r + 2], p0[r + 3]); mx = max3f(mx, p1[r], p1[r + 1]); my = max3f(my, p1[r + 2], p1[r + 3]); }
    mx = fmaxf(mx, my);
    { auto rr = __builtin_amdgcn_permlane32_swap(__float_as_uint(mx), __float_as_uint(mx), false, false); mx = fmaxf(__uint_as_float(rr[0]), __uint_as_float(rr[1])); }
    const float m_new = fmaxf(m_run, mx);
    const float alpha = __builtin_amdgcn_exp2f(m_run - m_new);
    m_run = m_new;
    p0 = p0 - m_new; p1 = p1 - m_new;
#pragma unroll
    for (int r = 0; r < 16; ++r) { p0[r] = __builtin_amdgcn_exp2f(p0[r]); p1[r] = __builtin_amdgcn_exp2f(p1[r]); }
    f32x16 sm = p0 + p1;
    f32x2v s2 = (f32x2v){sm[0], sm[1]} + (f32x2v){sm[2], sm[3]};
#pragma unroll
    for (int r = 4; r < 16; r += 2) s2 += (f32x2v){sm[r], sm[r + 1]};
    l_run = l_run * alpha + (s2[0] + s2[1]);
    o0 = o0 * alpha; o1 = o1 * alpha;
#pragma unroll
    for (int s = 0; s < 2; ++s) {
        u32x4 w; w.x = pk2(p0[8 * s], p0[8 * s + 1]); w.y = pk2(p0[8 * s + 2], p0[8 * s + 3]); w.z = pk2(p0[8 * s + 4], p0[8 * s + 5]); w.w = pk2(p0[8 * s + 6], p0[8 * s + 7]);
        pb[s] = __builtin_bit_cast(bf16x8, w);
        u32x4 w2; w2.x = pk2(p1[8 * s], p1[8 * s + 1]); w2.y = pk2(p1[8 * s + 2], p1[8 * s + 3]); w2.z = pk2(p1[8 * s + 4], p1[8 * s + 5]); w2.w = pk2(p1[8 * s + 6], p1[8 * s + 7]);
        pb[2 + s] = __builtin_bit_cast(bf16x8, w2);
    }
}
__device__ __forceinline__ void attn_pv(const bf16x8 (&vf)[8], const bf16x8 (&pb)[4], f32x16& o0, f32x16& o1) {
#pragma unroll
    for (int s = 0; s < 4; ++s) {
        o0 = __builtin_amdgcn_mfma_f32_32x32x16_bf16(vf[2 * s], pb[s], o0, 0, 0, 0);
        o1 = __builtin_amdgcn_mfma_f32_32x32x16_bf16(vf[2 * s + 1], pb[s], o1, 0, 0, 0);
    }
}
__device__ __forceinline__ void attn_phase(LAS unsigned char* lds, const bf16_t* __restrict__ Q, const bf16_t* __restrict__ KN, const bf16_t* __restrict__ KR,
                                           const bf16_t* __restrict__ VT, bf16_t* AO, int vcu, int G, int tid, int lane, int wave) {
    constexpr int KP = 104, VP = 136, KBUF = 128 * KP * 2, VBUF = 64 * VP * 2, BUF = KBUF + VBUF;
    if (wave >= 4) __builtin_amdgcn_s_setprio(1);
    const int r32 = lane & 31, hi = lane >> 5;
    const int pr = (r32 & ~12) | ((r32 & 4) << 1) | ((r32 & 8) >> 1);
    const int key_l = tid >> 3, kc = tid & 7, key_r = tid >> 2, rc = tid & 3, vd = tid >> 3, vc = tid & 7;
    for (int p = vcu; p < 512; p += G) {
#pragma unroll 1
        for (int half = 0; half < 2; ++half) {
            const int bh = p >> 3, pp = p & 7, qb = half ? 15 - pp : pp, b = bh >> 3, h = bh & 7;
            const size_t rowbase = (size_t)b * SEQ;
            const int qrow0 = qb * 256 + wave * 32, qc = qrow0 >> 6, NT2 = 2 * qb + 2;
            bf16x8 qf[6];
            { const bf16_t* qp = Q + (rowbase + qrow0 + r32) * NQ + h * 96 + 8 * hi;
#pragma unroll
              for (int ks = 0; ks < 6; ++ks) qf[ks] = *(const bf16x8*)(qp + 16 * ks); }
            const char* kbase = (const char*)(KN + rowbase * NKN + h * 64); const unsigned koff = (unsigned)(key_l * NKN + 8 * kc) * 2u;
            const char* rbase = (const char*)(KR + rowbase * 32); const unsigned roff = (unsigned)(key_r * 32 + 8 * rc) * 2u;
            const char* vbase = (const char*)(VT + (size_t)(h * 64) * MTOK + rowbase); const unsigned voff = (unsigned)((size_t)vd * MTOK + 8 * vc) * 2u;
            const int kdst = (key_l * KP + 8 * kc) * 2, rdst = (key_r * KP + 64 + 8 * rc) * 2, vdst = KBUF + (vd * VP + 8 * vc) * 2;
            u32x4 gk0, gk1, gr, gv0, gv1;
            gk0 = *(const u32x4*)(kbase + koff); gk1 = *(const u32x4*)(kbase + 64 * NKN * 2 + koff); gr = *(const u32x4*)(rbase + roff); gv0 = *(const u32x4*)(vbase + voff); gv1 = *(const u32x4*)(vbase + 128 + voff);
            *(LAS u32x4*)(lds + kdst) = gk0; *(LAS u32x4*)(lds + kdst + 64 * KP * 2) = gk1; *(LAS u32x4*)(lds + rdst) = gr; *(LAS u32x4*)(lds + vdst) = gv0; *(LAS u32x4*)(lds + vdst + 128) = gv1;
            __syncthreads();
            float m_run = -INFINITY, l_run = 0.f;
            f32x16 o0, o1;
#pragma unroll
            for (int r = 0; r < 16; ++r) { o0[r] = 0.f; o1[r] = 0.f; }
#define PREFETCH_NEXT() do { if (more) { const size_t ko = (size_t)(t + 1) * 128;                     const char* kb2 = kbase + ko * NKN * 2; const char* rb2 = rbase + ko * 64; const char* vb2 = vbase + ko * 2;                     gk0 = *(const u32x4*)(kb2 + koff); gk1 = *(const u32x4*)(kb2 + 64 * NKN * 2 + koff); gr = *(const u32x4*)(rb2 + roff); gv0 = *(const u32x4*)(vb2 + voff); gv1 = *(const u32x4*)(vb2 + 128 + voff); } } while (0)
            for (int t = 0; t < NT2; ++t) {
                const bool more = (t + 1 < NT2);
                const LAS unsigned char* buf = lds + (t & 1) * BUF;
                const LAS unsigned char* kA = buf + (pr * KP + 8 * hi) * 2; const LAS unsigned char* vA = buf + KBUF + (r32 * VP + 8 * hi) * 2;
                if (2 * t + 1 <= qc) {
                    bf16x8 kf[12], kf2[12], vf[8], vf2[8], pa[4], pb2[4]; f32x16 a0, a1, b0, b1;
                    attn_ldk(kf, kA);
                    __builtin_amdgcn_sched_barrier(0);
                    attn_qk(a0, a1, kf, qf);
                    attn_ldk(kf2, kA + 64 * KP * 2);
                    __builtin_amdgcn_sched_barrier(0);
                    attn_qk(b0, b1, kf2, qf);
                    attn_softmax(a0, a1, pa, o0, o1, m_run, l_run);
                    attn_ldv(vf, vA);
                    __builtin_amdgcn_sched_barrier(0);
                    PREFETCH_NEXT();
                    attn_ldv(vf2, vA + 128);
                    __builtin_amdgcn_sched_barrier(0);
                    attn_pv(vf, pa, o0, o1);
                    attn_softmax(b0, b1, pb2, o0, o1, m_run, l_run);
                    __builtin_amdgcn_sched_barrier(0);
                    attn_pv(vf2, pb2, o0, o1);
                } else if (2 * t <= qc) {
                    bf16x8 kf[12], vf[8], pa[4]; f32x16 a0, a1;
                    PREFETCH_NEXT();
                    attn_ldk(kf, kA);
                    __builtin_amdgcn_sched_barrier(0);
                    attn_qk(a0, a1, kf, qf);
                    __builtin_amdgcn_sched_barrier(0);
                    attn_ldv(vf, vA);
                    __builtin_amdgcn_sched_barrier(0);
                    attn_softmax(a0, a1, pa, o0, o1, m_run, l_run);
                    __builtin_amdgcn_sched_barrier(0);
                    attn_pv(vf, pa, o0, o1);
                } else { PREFETCH_NEXT(); }
                if (more) { LAS unsigned char* nb = lds + ((t + 1) & 1) * BUF;
                    *(LAS u32x4*)(nb + kdst) = gk0; *(LAS u32x4*)(nb + kdst + 64 * KP * 2) = gk1; *(LAS u32x4*)(nb + rdst) = gr; *(LAS u32x4*)(nb + vdst) = gv0; *(LAS u32x4*)(nb + vdst + 128) = gv1; }
                __syncthreads();
            }
            const float l = l_run + __shfl_xor(l_run, 32);
            const float inv = 1.0f / l;
            bf16_t* op = AO + (rowbase + qrow0 + r32) * DM + h * 64 + 8 * hi;
#pragma unroll
            for (int blk_ = 0; blk_ < 2; ++blk_) {
#pragma unroll
                for (int k2 = 0; k2 < 2; ++k2) {
                    const int g0 = 2 * k2, g1 = 2 * k2 + 1;
                    unsigned x0, x1, y0, y1;
                    if (blk_ == 0) { x0 = pk2(o0[4 * g0] * inv, o0[4 * g0 + 1] * inv); x1 = pk2(o0[4 * g0 + 2] * inv, o0[4 * g0 + 3] * inv); y0 = pk2(o0[4 * g1] * inv, o0[4 * g1 + 1] * inv); y1 = pk2(o0[4 * g1 + 2] * inv, o0[4 * g1 + 3] * inv); }
                    else           { x0 = pk2(o1[4 * g0] * inv, o1[4 * g0 + 1] * inv); x1 = pk2(o1[4 * g0 + 2] * inv, o1[4 * g0 + 3] * inv); y0 = pk2(o1[4 * g1] * inv, o1[4 * g1 + 1] * inv); y1 = pk2(o1[4 * g1 + 2] * inv, o1[4 * g1 + 3] * inv); }
                    const auto s0 = __builtin_amdgcn_permlane32_swap(x0, y0, false, false);
                    const auto s1 = __builtin_amdgcn_permlane32_swap(x1, y1, false, false);
                    u32x4 w; w.x = s0[0]; w.y = s1[0]; w.z = s0[1]; w.w = s1[1];
                    *(u32x4*)(op + 32 * blk_ + 16 * k2) = w;
                }
            }
        }
    }
    __builtin_amdgcn_s_setprio(0);
}

#undef PREFETCH_NEXT
__global__ void __launch_bounds__(512, 2) mega_fwd(Args a) {
    extern __shared__ __attribute__((aligned(16))) unsigned char lds_raw[];
    LAS unsigned char* lds = (LAS unsigned char*)lds_raw;
    cg::grid_group grid = cg::this_grid();
    if (threadIdx.x < 16) ((LAS unsigned*)(lds + 131072))[threadIdx.x] = 0u;
    __syncthreads();
    XcdBarrier xbar; { KARGS(); xbar = xcd_barrier_post((unsigned*)(KA->ws + WS_BAR), (volatile LAS unsigned*)(lds + 131072)); }
#define tid (otid())
#define lane (otid() & 63)
#define wave (__builtin_amdgcn_readfirstlane((int)(threadIdx.x >> 6)))
#define G ((int)gridDim.x)
#define bx ((int)blockIdx.x)
#define vcu ((G % 8 == 0) ? (bx % 8) * (G / 8) + bx / 8 : bx)
#define gw (vcu * 8 + wave)
#define NGW (G * 8)
#define gid (bx * 512 + tid)
#define NT_ALL (G * 512)
#define ws (KA->ws)
#define ADA ((float*)(ws + WS_ADA))
#define ROPE ((float*)(ws + WS_ROPE))
#define WSP ((bf16_t*)(ws + WS_WSP))
#define WIN ((bf16_t*)(ws + WS_WIN))
#define WUQ ((bf16_t*)(ws + WS_WUQ))
#define WUK ((bf16_t*)(ws + WS_WUK))
#define WUV ((bf16_t*)(ws + WS_WUV))
#define WO ((bf16_t*)(ws + WS_WO))
#define WUP ((bf16_t*)(ws + WS_WUP))
#define WDN ((bf16_t*)(ws + WS_WDN))
#define XN ((bf16_t*)(ws + WS_XN))
#define Z ((bf16_t*)(ws + WS_Z))
#define CQN ((bf16_t*)(ws + WS_CQN))
#define CKVN ((bf16_t*)(ws + WS_CKVN))
#define KR ((bf16_t*)(ws + WS_KR))
#define Q ((bf16_t*)(ws + WS_Q))
#define KN ((bf16_t*)(ws + WS_KN))
#define VT ((bf16_t*)(ws + WS_VT))
#define AO ((bf16_t*)(ws + WS_AO))
#define MB ((bf16_t*)(ws + WS_MB))
#define SIDE ((float*)(ws + WS_SIDE))
#define ACT ((bf16_t*)(ws + WS_ACT))
#define FB ((bf16_t*)(ws + WS_FB))
    { KARGS();
    {
        LAS float* cact = (LAS float*)lds;
        for (int i = tid; i < NB * DM; i += 512) cact[i] = silu_f(KA->c[i]);
        __syncthreads();
        for (int it = gw; it < 768; it += NGW) {
            const int cb = it % 24, kc = it / 24, n0 = cb * 256 + lane * 4, k0 = kc * 32;
            f32x4 acc[8];
#pragma unroll
            for (int b = 0; b < 8; ++b) acc[b] = (f32x4){0.f, 0.f, 0.f, 0.f};
#pragma unroll 8
            for (int kk = 0; kk < 32; ++kk) {
                const f32x4 w = *(const f32x4*)(KA->w_ada + (size_t)(k0 + kk) * 6144 + n0);
#pragma unroll
                for (int b = 0; b < 8; ++b) acc[b] += cact[b * DM + k0 + kk] * w;
            }
            if (kc == 0) { const f32x4 bv = *(const f32x4*)(KA->b_ada + n0);
#pragma unroll
                for (int b = 0; b < 8; ++b) acc[b] += bv; }
#pragma unroll
            for (int b = 0; b < 8; ++b)
#pragma unroll
                for (int e = 0; e < 4; ++e) __hip_atomic_fetch_add(ADA + b * 6144 + n0 + e, acc[b][e], __ATOMIC_RELAXED, __HIP_MEMORY_SCOPE_AGENT);
        }
        __syncthreads();
        LAS float* scr = (LAS float*)(lds + wave * 16384);
#pragma unroll 1
        for (int rep0_ = 0; rep0_ < (PROBE == 12 ? 2 : 1); ++rep0_) {
        constexpr int I_IN = 16 * 45, I_UQ = 4 * 24, I_UKV = 2 * 32, I_O = 16 * 32, I_UP = 16 * 176, I_DN = 44 * 32;
        constexpr int NITEMS = I_IN + I_UQ + I_UKV + I_O + I_UP + I_DN;
        for (int it = (gw + NGW - (768 % NGW)) % NGW; it < NITEMS; it += NGW) {
            int r = it;
            if (r < I_IN) { const int kb = r / 45, n0 = 32 * (r % 45); tr_item(KA->w_in, DM, 1440, WIN, 64 * kb, n0, n0 + (n0 >= 416 ? 96 : 0), scr, lane); continue; } r -= I_IN;
            if (r < I_UQ) { const int kb = r / 24, n0 = 32 * (r % 24); tr_item(KA->w_uq, QL, NQ, WUQ, 64 * kb, n0, n0, scr, lane); continue; } r -= I_UQ;
            if (r < I_UKV) { const int kb = r / 32, n0 = 32 * (r % 32); const int hh = n0 >> 7, q4 = (n0 & 127) >> 5;
                tr_item(KA->w_ukv, KVL, 1024, q4 < 2 ? WUK : WUV, 64 * kb, n0, hh * 64 + 32 * (q4 & 1), scr, lane); continue; } r -= I_UKV;
            if (r < I_O) { const int kb = r / 32, n0 = 32 * (r % 32); tr_item(KA->w_out, DM, DM, WO, 64 * kb, n0, n0, scr, lane); continue; } r -= I_O;
            if (r < I_UP) { const int kb = r / 176, n0 = 32 * (r % 176); const int isb = n0 >= DFF, j = isb ? n0 - DFF : n0;
                tr_item(KA->w_up, DM, NUP, WUP, 64 * kb, n0, 256 * (j >> 7) + 128 * isb + (j & 127), scr, lane, true); continue; } r -= I_UP;
            { const int kb = r / 32, n0 = 32 * (r % 32); tr_item(KA->w_down, DFF, DM, WDN, 64 * kb, n0, n0, scr, lane); }
        }
        for (int i = gid; i < 96 * 1024 / 8; i += NT_ALL) *(u32x4*)(WIN + (size_t)416 * 1024 + (size_t)i * 8) = (u32x4){0u, 0u, 0u, 0u};
        for (int i = gid; i < 8 * 128 * 128; i += NT_ALL) { const int ii = (i >> 7) & 127, jj = i & 127; const float v = ((jj >> 6) <= (ii >> 6)) ? KA->w_spatial[i] : 0.f; WSP[i] = (bf16_t)(pk2(v, 0.f) & 0xffffu); }
        for (int i = gid; i < SEQ * 16; i += NT_ALL) { const int s = i >> 4, f = i & 15;
            const float inv = exp2f(-(float)f * (13.287712379549449f / 16.0f));
            const float ang = (float)s * inv;
            const double rev = (double)ang * 0.15915494309189535; const float fr = (float)(rev - floor(rev));
            ROPE[2 * i] = __builtin_amdgcn_cosf(fr); ROPE[2 * i + 1] = __builtin_amdgcn_sinf(fr); }
        }
    }
    }
    { KARGS(); if (KA->out == nullptr) grid.sync(); }
    GSYNC();

    { KARGS();
    for (int idx = gid; idx < NB * DM; idx += NT_ALL) { const int b = idx >> 10, c = idx & 1023; const float* ad = ADA + b * 6144; float* gvp = (float*)(ws + WS_GV);
        gvp[idx] = KA->g_post_mix[c] * ad[2048 + c]; gvp[8192 + idx] = KA->g_pre_ffn[c] * (1.0f + ad[4096 + c]); gvp[16384 + idx] = ad[3072 + c]; gvp[24576 + idx] = KA->g_post_ffn[c] * ad[5120 + c]; }

#pragma unroll 1
    for (int rep_ = 0; rep_ < (PROBE == 7 ? 2 : 1); ++rep_) {
    for (int r0 = gw * 16; r0 < MTOK; r0 += NGW * 16) {
        const int b = r0 >> 12; const float* ad = ADA + b * 6144;
        f32x4 A1[4], B1[4];
#pragma unroll
        for (int j = 0; j < 4; ++j) { const int c = 4 * lane + 256 * j; const f32x4 g = *(const f32x4*)(KA->g_pre_mix + c), sc = *(const f32x4*)(ad + 1024 + c); A1[j] = g * (1.0f + sc); B1[j] = *(const f32x4*)(ad + c); }
        f32x4 vn[4];
#pragma unroll
        for (int j = 0; j < 4; ++j) vn[j] = __builtin_nontemporal_load((const f32x4*)(KA->x + (size_t)r0 * DM + 4 * lane + 256 * j));
        for (int rr = 0; rr < 16; ++rr) {
            const size_t row = (size_t)(r0 + rr), nrow = (size_t)(r0 + (rr < 15 ? rr + 1 : 15));
            f32x4 v[4]; float ss = 0.f;
#pragma unroll
            for (int j = 0; j < 4; ++j) { v[j] = vn[j]; vn[j] = __builtin_nontemporal_load((const f32x4*)(KA->x + nrow * DM + 4 * lane + 256 * j)); ss += (v[j][0] * v[j][0] + v[j][1] * v[j][1]) + (v[j][2] * v[j][2] + v[j][3] * v[j][3]); }
            const float rs = rsqrtf(wave_sum(ss) * (1.0f / DM) + EPS);
#pragma unroll
            for (int j = 0; j < 4; ++j) { const f32x4 o = v[j] * rs * A1[j] + B1[j]; u32x2 w; w.x = pk2(o[0], o[1]); w.y = pk2(o[2], o[3]); *(u32x2*)(XN + row * DM + 4 * lane + 256 * j) = w; }
        }
    }
    }
    }
    GSYNC();

    { KARGS();
#pragma unroll 1
    for (int rep_ = 0; rep_ < (PROBE == 10 ? 2 : 1); ++rep_) {
    { pg8::Gemm g{XN, WIN, MTOK, NZ, DM}; pg8::StaticOrder S; S.init(MTOK, NZ, G, bx); pg8::EpiZ2 E{Z, CQN, CKVN, KR, KA->g_q, KA->g_kv, ROPE, (LAS float*)(lds + 131072 + 1024)};
      pg8::gemm_phase<pg8::EpiZ2, pg8::StaticOrder, true, true>(lds, g, S, E); }
    }
    }
    GSYNC();

    { KARGS();
#pragma unroll 1
    for (int rep_ = 0; rep_ < (PROBE == 3 ? 2 : 1); ++rep_) {
    {
        constexpr int VLP = 136;
        LAS bf16_t* VLT = (LAS bf16_t*)lds;
        const int r32 = lane & 31, hi = lane >> 5, iblk = wave >> 1, dblk = wave & 1;
        const int jt = tid >> 2, qd = tid & 3;
        u32x4 r0, r1; f32x4 lgv[4], lbv[4];
        const int ustep = (G == 256) ? 1 : G;
        const int jx = vcu & 31;
        const int u0 = (G == 256) ? (256 * (vcu >> 5) + (jx < 16 ? 7 * jx : 112 + 9 * (jx - 16))) : vcu;
        const int ucnt = (G == 256) ? (bx < 128 ? 7 : 9) : (vcu < 2048 ? (2047 - vcu) / G + 1 : 0);
        if (ucnt > 0) { const bf16_t* vp = Z + ((size_t)(u0 >> 3) * 128 + jt) * NZ + 1024 + (u0 & 7) * 64 + 16 * qd; r0 = *(const u32x4*)vp; r1 = *(const u32x4*)(vp + 8);
#pragma unroll
            for (int e4 = 0; e4 < 4; ++e4) { lgv[e4] = *(const f32x4*)(KA->gm_ln_g + (u0 & 7) * 64 + 16 * qd + 4 * e4); lbv[e4] = *(const f32x4*)(KA->gm_ln_b + (u0 & 7) * 64 + 16 * qd + 4 * e4); } }
        for (int ui = 0, u = u0; ui < ucnt; ++ui, u += ustep) {
            const int blk = u >> 3, h = u & 7; const size_t t0 = (size_t)blk * 128;
            {
                float xv[16];
                xv[0] = bf_lo(r0.x); xv[1] = bf_hi(r0.x); xv[2] = bf_lo(r0.y); xv[3] = bf_hi(r0.y); xv[4] = bf_lo(r0.z); xv[5] = bf_hi(r0.z); xv[6] = bf_lo(r0.w); xv[7] = bf_hi(r0.w);
                xv[8] = bf_lo(r1.x); xv[9] = bf_hi(r1.x); xv[10] = bf_lo(r1.y); xv[11] = bf_hi(r1.y); xv[12] = bf_lo(r1.z); xv[13] = bf_hi(r1.z); xv[14] = bf_lo(r1.w); xv[15] = bf_hi(r1.w);
                float sm = 0.f;
#pragma unroll
                for (int e = 0; e < 16; ++e) sm += xv[e];
                sm += __shfl_xor(sm, 1); sm += __shfl_xor(sm, 2);
                const float mu = sm * (1.0f / 64.0f); float q = 0.f;
#pragma unroll
                for (int e = 0; e < 16; ++e) { xv[e] -= mu; q += xv[e] * xv[e]; }
                q += __shfl_xor(q, 1); q += __shfl_xor(q, 2);
                const float rstd = rsqrtf(q * (1.0f / 64.0f) + EPS);
#pragma unroll
                for (int e = 0; e < 16; ++e) { const float y = xv[e] * rstd * lgv[e >> 2][e & 3] + lbv[e >> 2][e & 3]; VLT[(16 * qd + e) * VLP + jt] = (bf16_t)(pk2(y, 0.f) & 0xffffu); }
            }
            const int un = u + ustep;
            if (ui + 1 < ucnt) { const bf16_t* vp = Z + ((size_t)(un >> 3) * 128 + jt) * NZ + 1024 + (un & 7) * 64 + 16 * qd; r0 = *(const u32x4*)vp; r1 = *(const u32x4*)(vp + 8);
#pragma unroll
                for (int e4 = 0; e4 < 4; ++e4) { lgv[e4] = *(const f32x4*)(KA->gm_ln_g + (un & 7) * 64 + 16 * qd + 4 * e4); lbv[e4] = *(const f32x4*)(KA->gm_ln_b + (un & 7) * 64 + 16 * qd + 4 * e4); } }
            const int itok = 32 * iblk + r32;
            const bf16_t* up = Z + (t0 + itok) * NZ + 512 + h * 64 + 32 * dblk + 4 * hi;
            u32x2 uu[4];
#pragma unroll
            for (int g = 0; g < 4; ++g) uu[g] = *(const u32x2*)(up + 8 * g);
            const float bsp = KA->b_spatial[h * 128 + itok];
            bf16x8 wf[8];
            { const bf16_t* wp = WSP + ((size_t)h * 128 + itok) * 128 + 8 * hi;
#pragma unroll
              for (int s = 0; s < 8; ++s) if (s < 4 || iblk >= 2) wf[s] = *(const bf16x8*)(wp + 16 * s); }
            __syncthreads();
            {
                f32x16 acc;
#pragma unroll
                for (int r = 0; r < 16; ++r) acc[r] = 0.f;
                const LAS bf16_t* vl = VLT + (32 * dblk + r32) * VLP + 8 * hi;
#pragma unroll
                for (int s = 0; s < 8; ++s) if (s < 4 || iblk >= 2) {
                    const bf16x8 vf = *(const LAS bf16x8*)(vl + 16 * s);
                    acc = __builtin_amdgcn_mfma_f32_32x32x16_bf16(vf, wf[s], acc, 0, 0, 0);
                }
                bf16_t* op = AO + (t0 + itok) * DM + 512 + h * 64 + 32 * dblk + 4 * hi;
#pragma unroll
                for (int g = 0; g < 4; ++g) {
                    u32x2 w; w.x = pk2(bf_lo(uu[g].x) * (acc[4 * g] + bsp), bf_hi(uu[g].x) * (acc[4 * g + 1] + bsp)); w.y = pk2(bf_lo(uu[g].y) * (acc[4 * g + 2] + bsp), bf_hi(uu[g].y) * (acc[4 * g + 3] + bsp));
                    *(u32x2*)(op + 8 * g) = w;
                }
            }
            __syncthreads();
        }
    }
    }
    }

    { KARGS();
#pragma unroll 1
    for (int rep_ = 0; rep_ < (PROBE == 4 ? 2 : 1); ++rep_) {
    { int Kh = QL; asm volatile("" : "+s"(Kh)); pg8::Gemm g{CQN, WUQ, MTOK, NQ, Kh}; pg8::StaticOrder S; S.init(MTOK, NQ, G, bx); pg8::EpiQ E{Q, ROPE};
      pg8::gemm_phase<pg8::EpiQ, pg8::StaticOrder, true, true>(lds, g, S, E); }
    }
    { KARGS();
    { int Kh = KVL; asm volatile("" : "+s"(Kh)); pg8::Gemm g{CKVN, WUK, MTOK, NKN, Kh}; pg8::StaticOrder S; S.init(MTOK, NKN, G, bx); pg8::EpiBf16 E{KN, NKN, 1 << 30};
      pg8::gemm_phase<pg8::EpiBf16, pg8::StaticOrder, true, true>(lds, g, S, E); }
    }
    { KARGS();
    { int Kh = KVL; asm volatile("" : "+s"(Kh)); pg8::Gemm g{WUV, CKVN, 512, MTOK, Kh}; pg8::StaticOrder S; S.init(512, MTOK, G, bx); pg8::EpiBf16 E{VT, MTOK, 1 << 30};
      pg8::gemm_phase<pg8::EpiBf16, pg8::StaticOrder, true, true>(lds, g, S, E); }
    }
    }
    GSYNC();

    { KARGS();
    attn_phase(lds, Q, KN, KR, VT, AO, vcu, G, tid, lane, wave);
#if PROBE == 2
    __syncthreads();
    attn_phase(lds, Q, KN, KR, VT, AO, vcu, G, tid, lane, wave);
#endif
    }
    GSYNC();

    if (G == 256) {
#pragma unroll 1
        for (int call = 0; call < 2; ++call) { KARGS();
            pg8::Gemm g{AO + (size_t)call * (MTOK / 2) * DM, WO, MTOK / 2, DM, DM}; pg8::StaticOrder S; S.init(MTOK / 2, DM, G, bx);
            pg8::PanelSS st1{(float*)(ws + WS_XB) + 1 * 131072, (unsigned*)(ws + WS_CNT) + 1 * 8192, 64 * call, EPS};
            pg8::PanelSS st2{(float*)(ws + WS_XB) + 2 * 131072, (unsigned*)(ws + WS_CNT) + 2 * 8192, 64 * call, EPS};
            pg8::Unit u0; u0.pm = 0; u0.pn = 0; (void)S.next(0, u0);
            const float* gvb = (const float*)(ws + WS_GV) + (call * 4 + (u0.pm >> 4)) * DM;
            pg8::EpiRmsResRms E2{KA->x, KA->out, XN, gvb, gvb + 8192, gvb + 16384, call * (MTOK / 2), st1, st2};
            pg8::gemm_phase<pg8::EpiRmsResRms, pg8::StaticOrder, false, true>(lds, g, S, E2); }
        GSYNC();
    } else {
    { KARGS();
#pragma unroll 1
    for (int rep_ = 0; rep_ < (PROBE == 8 ? 2 : 1); ++rep_) {
    { pg8::Gemm g{AO, WO, MTOK, DM, DM}; pg8::StaticOrder S; S.init(MTOK, DM, G, bx); pg8::EpiBf16 E{MB, DM, 1 << 30};
      pg8::gemm_phase<pg8::EpiBf16, pg8::StaticOrder, true, true>(lds, g, S, E); }
    }
    }
    GSYNC();

    { KARGS();
#pragma unroll 1
    for (int rep_ = 0; rep_ < (PROBE == 6 ? 2 : 1); ++rep_) {
    for (int r0 = gw * 16; r0 < MTOK; r0 += NGW * 16) {
        const int b = r0 >> 12; const float* ad = ADA + b * 6144;
        f32x4 G1[4], G2[4], S2[4];
#pragma unroll
        for (int j = 0; j < 4; ++j) { const int c = 4 * lane + 256 * j;
            G1[j] = *(const f32x4*)(KA->g_post_mix + c) * *(const f32x4*)(ad + 2048 + c);
            G2[j] = *(const f32x4*)(KA->g_pre_ffn + c) * (1.0f + *(const f32x4*)(ad + 4096 + c));
            S2[j] = *(const f32x4*)(ad + 3072 + c); }
        u32x2 mn[4]; f32x4 xn[4];
#pragma unroll
        for (int j = 0; j < 4; ++j) { mn[j] = *(const u32x2*)(MB + (size_t)r0 * DM + 4 * lane + 256 * j); xn[j] = *(const f32x4*)(KA->x + (size_t)r0 * DM + 4 * lane + 256 * j); }
        for (int rr = 0; rr < 16; ++rr) {
            const size_t row = (size_t)(r0 + rr), nrow = (size_t)(r0 + (rr < 15 ? rr + 1 : 15));
            f32x4 mv[4], xv[4]; float ss = 0.f;
#pragma unroll
            for (int j = 0; j < 4; ++j) { const u32x2 w = mn[j]; mv[j] = (f32x4){bf_lo(w.x), bf_hi(w.x), bf_lo(w.y), bf_hi(w.y)}; xv[j] = xn[j];
                mn[j] = *(const u32x2*)(MB + nrow * DM + 4 * lane + 256 * j); xn[j] = *(const f32x4*)(KA->x + nrow * DM + 4 * lane + 256 * j);
                ss += (mv[j][0] * mv[j][0] + mv[j][1] * mv[j][1]) + (mv[j][2] * mv[j][2] + mv[j][3] * mv[j][3]); }
            const float rs = rsqrtf(wave_sum(ss) * (1.0f / DM) + EPS);
            float s2 = 0.f;
#pragma unroll
            for (int j = 0; j < 4; ++j) { xv[j] = xv[j] + mv[j] * rs * G1[j]; *(f32x4*)(KA->out + row * DM + 4 * lane + 256 * j) = xv[j];
                s2 += (xv[j][0] * xv[j][0] + xv[j][1] * xv[j][1]) + (xv[j][2] * xv[j][2] + xv[j][3] * xv[j][3]); }
            const float r2 = rsqrtf(wave_sum(s2) * (1.0f / DM) + EPS);
#pragma unroll
            for (int j = 0; j < 4; ++j) { const f32x4 o = xv[j] * r2 * G2[j] + S2[j]; u32x2 w; w.x = pk2(o[0], o[1]); w.y = pk2(o[2], o[3]); *(u32x2*)(XN + row * DM + 4 * lane + 256 * j) = w; }
        }
    }
    }
    }
    GSYNC();
    }

    { KARGS();
#pragma unroll 1
    for (int rep_ = 0; rep_ < (PROBE == 9 ? 2 : 1); ++rep_) {
    { pg8::Gemm g{XN, WUP, MTOK, NUP, DM}; pg8::StaticOrder S; S.init(MTOK, NUP, G, bx); pg8::EpiConv E{ACT, SIDE, KA->conv_w, KA->conv_b, (LAS float*)(lds + 131072 + 1024)};
      pg8::gemm_phase<pg8::EpiConv, pg8::StaticOrder, true, true>(lds, g, S, E); }
    }
    }
    GSYNC();

    { KARGS();
    for (int idx = gid; idx < 128 * DFF; idx += NT_ALL) {
        const int pm = idx / DFF, j = idx - pm * DFF;
        if ((pm & 15) == 0) continue;
        const float* sp = SIDE + ((size_t)((pm - 1) * 4 + 2) * 2) * DFF + j;
        const float* sc = SIDE + ((size_t)(pm * 4 + 0) * 2) * DFF + j;
        const float p2a = sp[0], p2b = sp[DFF], p1a = sp[2 * DFF], p1b = sp[3 * DFF], x0a = sc[0], x0b = sc[DFF], x1a = sc[2 * DFF], x1b = sc[3 * DFF];
        const float wa0 = KA->conv_w[j], wa1 = KA->conv_w[NUP + j], wa2 = KA->conv_w[2 * NUP + j], wb0 = KA->conv_w[DFF + j], wb1 = KA->conv_w[NUP + DFF + j], wb2 = KA->conv_w[2 * NUP + DFF + j];
        const float ba = KA->conv_b[j], bb = KA->conv_b[DFF + j];
        const float ya0 = ba + wa0 * p2a + wa1 * p1a + wa2 * x0a, ya1 = ba + wa0 * p1a + wa1 * x0a + wa2 * x1a;
        const float yb0 = bb + wb0 * p2b + wb1 * p1b + wb2 * x0b, yb1 = bb + wb0 * p1b + wb1 * x0b + wb2 * x1b;
        ACT[(size_t)(pm * 256) * DFF + j] = (bf16_t)(pk2(silu_f(ya0) * yb0, 0.f) & 0xffffu);
        ACT[(size_t)(pm * 256 + 1) * DFF + j] = (bf16_t)(pk2(silu_f(ya1) * yb1, 0.f) & 0xffffu);
    }
    }
    GSYNC();

    if (G == 256) {
#pragma unroll 1
        for (int call = 0; call < 2; ++call) { KARGS();
            pg8::Gemm g{ACT + (size_t)call * (MTOK / 2) * DFF, WDN, MTOK / 2, DM, DFF}; pg8::StaticOrder S; S.init(MTOK / 2, DM, G, bx);
            pg8::PanelSS st{(float*)(ws + WS_XB), (unsigned*)(ws + WS_CNT), 64 * call, EPS};
            pg8::Unit u0; u0.pm = 0; u0.pn = 0; (void)S.next(0, u0);
            pg8::EpiRmsRes E2{KA->out, KA->out, (const float*)(ws + WS_GV) + 24576 + (call * 4 + (u0.pm >> 4)) * DM, call * (MTOK / 2), st};
            pg8::gemm_phase<pg8::EpiRmsRes, pg8::StaticOrder, false, true>(lds, g, S, E2); }
    } else {
    { KARGS();
#pragma unroll 1
    for (int rep_ = 0; rep_ < (PROBE == 11 ? 2 : 1); ++rep_) {
    { pg8::Gemm g{ACT, WDN, MTOK, DM, DFF}; pg8::StaticOrder S; S.init(MTOK, DM, G, bx); pg8::EpiBf16 E{FB, DM, 1 << 30};
      pg8::gemm_phase<pg8::EpiBf16, pg8::StaticOrder, true, true>(lds, g, S, E); }
    }
    }
    GSYNC();

    { KARGS();
    for (int r0 = gw * 16; r0 < MTOK; r0 += NGW * 16) {
        const int b = r0 >> 12; const float* ad = ADA + b * 6144;
        f32x4 G3[4];
#pragma unroll
        for (int j = 0; j < 4; ++j) { const int c = 4 * lane + 256 * j; G3[j] = *(const f32x4*)(KA->g_post_ffn + c) * *(const f32x4*)(ad + 5120 + c); }
        u32x2 fn[4]; f32x4 xn[4];
#pragma unroll
        for (int j = 0; j < 4; ++j) { fn[j] = *(const u32x2*)(FB + (size_t)r0 * DM + 4 * lane + 256 * j); xn[j] = *(const f32x4*)(KA->out + (size_t)r0 * DM + 4 * lane + 256 * j); }
        for (int rr = 0; rr < 16; ++rr) {
            const size_t row = (size_t)(r0 + rr); const bool last = (rr == 15); const size_t nrow = (size_t)(r0 + (last ? 15 : rr + 1));
            f32x4 fv[4], x1[4]; float ss = 0.f;
#pragma unroll
            for (int j = 0; j < 4; ++j) { const u32x2 w = fn[j]; fv[j] = (f32x4){bf_lo(w.x), bf_hi(w.x), bf_lo(w.y), bf_hi(w.y)}; x1[j] = xn[j];
                if (!last) { fn[j] = *(const u32x2*)(FB + nrow * DM + 4 * lane + 256 * j); xn[j] = *(const f32x4*)(KA->out + nrow * DM + 4 * lane + 256 * j); }
                ss += (fv[j][0] * fv[j][0] + fv[j][1] * fv[j][1]) + (fv[j][2] * fv[j][2] + fv[j][3] * fv[j][3]); }
            const float rs = rsqrtf(wave_sum(ss) * (1.0f / DM) + EPS);
#pragma unroll
            for (int j = 0; j < 4; ++j) *(f32x4*)(KA->out + row * DM + 4 * lane + 256 * j) = x1[j] + fv[j] * rs * G3[j];
        }
    }
    }
    }
}

#undef tid
#undef lane
#undef wave
#undef G
#undef bx
#undef vcu
#undef gw
#undef NGW
#undef gid
#undef NT_ALL
#undef ws
#undef ADA
#undef ROPE
#undef WSP
#undef WIN
#undef WUQ
#undef WUK
#undef WUV
#undef WO
#undef WUP
#undef WDN
#undef XN
#undef Z
#undef CQN
#undef CKVN
#undef KR
#undef Q
#undef KN
#undef VT
#undef AO
#undef MB
#undef SIDE
#undef ACT
#undef FB
extern "C" void kernel_launch(void* const* d_in, const int* in_sizes, int n_in, void* d_out, int out_size, void* d_ws, size_t ws_size, hipStream_t stream) {
    static int grid = 0;
    if (grid == 0) {
        if (n_in != 22 || ws_size < WS_END) { fprintf(stderr, "kernel_launch: unexpected inputs (n_in %d, ws %zu)\n", n_in, ws_size); grid = -1; return; }
        int dev = 0, cus = 0, per_cu = 0;
        (void)hipGetDevice(&dev); (void)hipDeviceGetAttribute(&cus, hipDeviceAttributeMultiprocessorCount, dev);
        (void)hipFuncSetAttribute((const void*)mega_fwd, hipFuncAttributeMaxDynamicSharedMemorySize, LDS_BYTES);
        if (hipOccupancyMaxActiveBlocksPerMultiprocessor(&per_cu, (const void*)mega_fwd, 512, LDS_BYTES) != hipSuccess || per_cu < 1) per_cu = 1;
        (void)hipGetLastError();
        grid = cus * per_cu; if (grid <= 0) grid = 256;
    }
    if (grid < 0) return;
    (void)hipMemsetAsync((char*)d_ws + WS_ADA, 0, CTL_ZERO_BYTES, stream);
    Args a{};
    const float** ap = (const float**)&a;
    for (int i = 0; i < 22; ++i) ap[i] = (const float*)d_in[i];
    a.out = (float*)d_out; a.ws = (unsigned char*)d_ws;
    void* args[] = {&a};
    hipError_t e = hipLaunchCooperativeKernel((const void*)mega_fwd, dim3(grid), dim3(512), args, LDS_BYTES, stream);
    if (e != hipSuccess) fprintf(stderr, "cooperative launch failed: %s (grid %d)\n", hipGetErrorString(e), grid);
}
```

```cpp
#define PROBE 0
#include <hip/hip_runtime.h>
#include <hip/hip_cooperative_groups.h>
#include <cstdio>
#include <cstdint>
namespace cg = cooperative_groups;
#ifndef PROBE
#define PROBE 0
#endif
#if PROBE == 1
#define GSYNC() do { xcd_barrier(xbar); xcd_barrier(xbar); } while (0)
#else
#define GSYNC() xcd_barrier(xbar)
#endif

#define LAS __attribute__((address_space(3)))
typedef unsigned short bf16_t;
typedef short bf16x8 __attribute__((ext_vector_type(8)));
typedef float f32x4 __attribute__((ext_vector_type(4)));
typedef float f32x16 __attribute__((ext_vector_type(16)));
typedef unsigned u32x4 __attribute__((ext_vector_type(4)));
typedef unsigned u32x2 __attribute__((ext_vector_type(2)));
typedef float f32x2_t __attribute__((ext_vector_type(2)));
typedef __bf16 bf16x2_t __attribute__((ext_vector_type(2)));

__device__ __forceinline__ unsigned pk2(float lo, float hi) { f32x2_t v = {lo, hi}; bf16x2_t b = __builtin_convertvector(v, bf16x2_t); return __builtin_bit_cast(unsigned, b); }
__device__ __forceinline__ float bf_lo(unsigned u) { return __uint_as_float(u << 16); }
__device__ __forceinline__ float bf_hi(unsigned u) { return __uint_as_float(u & 0xffff0000u); }
__device__ __forceinline__ float wave_sum(float v) {
#pragma unroll
    for (int o = 1; o < 64; o <<= 1) v += __shfl_xor(v, o);
    return v;
}
__device__ __forceinline__ float gelu_tanh(float x) {
    const float t = x * (1.0f + 0.044715f * x * x);
    const float e = __builtin_amdgcn_exp2f(-2.0f * 0.7978845608028654f * 1.4426950408889634f * t);
    return x * __builtin_amdgcn_rcpf(1.0f + e);
}
__device__ __forceinline__ float silu_f(float x) { return x * __builtin_amdgcn_rcpf(1.0f + __builtin_amdgcn_exp2f(-1.4426950408889634f * x)); }

constexpr int NB = 8, SEQ = 4096, DM = 1024, MTOK = NB * SEQ;
constexpr int NZ = 1536;
constexpr int QL = 256, KVL = 128, NQ = 768, NKN = 512, DFF = 2816, NUP = 5632;
constexpr float EPS = 1e-6f;
constexpr float C2 = 0.10206207261596575f * 1.4426950408889634f;

constexpr size_t MiB = 1u << 20;
constexpr size_t WS_ADA = 0;
constexpr size_t CTL_ZERO_BYTES = 512 * 1024;
constexpr size_t WS_CNT = 256 * 1024;
constexpr size_t WS_GV = 1 * MiB + 768 * 1024;
constexpr size_t WS_XB = 25 * MiB;
constexpr size_t WS_BAR = 200 * 1024;
constexpr size_t WS_ROPE = 1 * MiB;
constexpr size_t WS_WSP = 1 * MiB + 512 * 1024;
constexpr size_t WS_WIN = 2 * MiB;
constexpr size_t WS_WUQ = 5 * MiB;
constexpr size_t WS_WUK = 5 * MiB + 512 * 1024;
constexpr size_t WS_WUV = 5 * MiB + 768 * 1024;
constexpr size_t WS_WO = 6 * MiB;
constexpr size_t WS_WUP = 8 * MiB;
constexpr size_t WS_WDN = 19 * MiB;
constexpr size_t WS_XN = 32 * MiB;
constexpr size_t WS_Z = 96 * MiB;
constexpr size_t WS_CQN = 192 * MiB;
constexpr size_t WS_CKVN = 208 * MiB;
constexpr size_t WS_KR = 216 * MiB;
constexpr size_t WS_Q = 218 * MiB;
constexpr size_t WS_KN = 266 * MiB;
constexpr size_t WS_VT = 298 * MiB;
constexpr size_t WS_AO = 330 * MiB;
constexpr size_t WS_MB = 394 * MiB;
constexpr size_t WS_SIDE = 96 * MiB;
constexpr size_t WS_ACT = 272 * MiB;
constexpr size_t WS_FB = 448 * MiB;
constexpr size_t WS_END = 512 * MiB;

constexpr int LDS_BYTES = 147456;

struct Args {
    const float* x; const float* c; const float* w_ada; const float* b_ada; const float* g_pre_mix; const float* g_post_mix;
    const float* w_in; const float* g_q; const float* w_uq; const float* g_kv; const float* w_ukv; const float* gm_ln_g; const float* gm_ln_b;
    const float* w_spatial; const float* b_spatial; const float* w_out; const float* g_pre_ffn; const float* g_post_ffn;
    const float* w_up; const float* conv_w; const float* conv_b; const float* w_down;
    float* out; unsigned char* ws;
};

#define CAS __attribute__((address_space(4)))
__device__ __forceinline__ const CAS Args* kargs() { const CAS void* p = (const CAS void*)__builtin_amdgcn_kernarg_segment_ptr(); asm volatile("" : "+s"(p)); return (const CAS Args*)p; }
#define KARGS() const CAS Args* KA = kargs()
__device__ __forceinline__ int otid() { int t = threadIdx.x; asm volatile("" : "+v"(t)); return t; }

namespace pg8 {
#define PG8_LAS __attribute__((address_space(3)))
constexpr int BM = 256, BK = 64, HALF = 128, HTB = HALF * BK * 2, STAGE_BYTES = 8 * HTB, NXCD = 8, WGM = 2;
__host__ __device__ __forceinline__ int lds_byte(int r, int c) { const int st = (r >> 4) * 2 + (c >> 5), rr = r & 15, cc = c & 31, ob = rr * 64 + cc * 2; return st * 1024 + (ob ^ (((ob >> 9) & 1) << 5)); }
__host__ __device__ __forceinline__ void stage_rc(int b, int& R, int& C) { const int st = b / 1024, sb = b % 1024, swz = sb ^ (((sb >> 9) & 1) << 5); R = (st >> 1) * 16 + swz / 64; C = (st & 1) * 32 + (swz % 64) / 2; }
__host__ __device__ __forceinline__ int perm32(int rho) { const int n = rho >> 4, i = rho & 15; return 8 * (i >> 2) + 4 * n + (i & 3); }

__device__ __forceinline__ unsigned cvt_pk_bf16(float lo, float hi) { unsigned r; asm volatile("v_cvt_pk_bf16_f32 %0, %1, %2" : "=v"(r) : "v"(lo), "v"(hi)); return r; }
struct Unit { int pm, pn; };
struct Gemm { const bf16_t* A; const bf16_t* Bt; int M, N, K; };

struct StaticOrder {
    int nM, nN, nwg, G, c;
    __host__ __device__ __forceinline__ void init(int M, int N, int G_, int c_) { nM = M / BM; nN = N / BM; nwg = nM * nN; G = G_; c = c_; }
    __host__ __device__ __forceinline__ bool next(int i, Unit& u) const {
        const long L = (long)i * G + c; if (L >= nwg) return false;
        int wgid = (int)L; { const int q = nwg / NXCD, r = nwg % NXCD, xcd = wgid % NXCD, off = wgid / NXCD; wgid = (xcd < r ? xcd * (q + 1) : r * (q + 1) + (xcd - r) * q) + off; }
        const int nig = WGM * nN, gid = wgid / nig, fm = gid * WGM, gsz = (nM - fm) < WGM ? (nM - fm) : WGM;
        u.pm = fm + ((wgid % nig) % gsz); u.pn = (wgid % nig) / gsz; return true;
    }
    __device__ __forceinline__ void a_ready(const Unit&) const {}
    __device__ __forceinline__ void done(const Unit&) const {}
};

struct EpiBf16 {
    static constexpr bool PERM = true, AFTER_DRAIN = false, NONTRANS = false;
    bf16_t* O; int ldc; int gelu_from;
    __device__ __forceinline__ void operator()(const f32x4 (&acc)[2][2][4][2], const Unit& u, int wr, int wc, int fr, int fq) const {
        const int row0 = u.pm * BM + wr * 64 + fr; const int col0 = u.pn * BM + wc * 32 + 8 * fq;
        const bool act = u.pn >= gelu_from;
#pragma unroll
        for (int ai = 0; ai < 2; ++ai)
#pragma unroll
            for (int m = 0; m < 4; ++m) { bf16_t* rowp = O + (size_t)(row0 + ai * HALF + m * 16) * ldc + col0;
#pragma unroll
                for (int bj = 0; bj < 2; ++bj) { f32x4 v0 = acc[ai][bj][m][0], v1 = acc[ai][bj][m][1];
                    if (act) {
#pragma unroll
                        for (int e = 0; e < 4; ++e) { v0[e] = gelu_tanh(v0[e]); v1[e] = gelu_tanh(v1[e]); } }
                    u32x4 w; w.x = cvt_pk_bf16(v0[0], v0[1]); w.y = cvt_pk_bf16(v0[2], v0[3]); w.z = cvt_pk_bf16(v1[0], v1[1]); w.w = cvt_pk_bf16(v1[2], v1[3]);
                    *(u32x4*)(rowp + bj * HALF) = w; } }
    }
};
struct EpiZ2 {
    static constexpr bool PERM = true, AFTER_DRAIN = false, NONTRANS = false;
    bf16_t* Zo; bf16_t* CQNo; bf16_t* CKVNo; bf16_t* KRo; const float* gq; const float* gkv; const float* rope; PG8_LAS float* P;
    __device__ __forceinline__ void operator()(const f32x4 (&acc)[2][2][4][2], const Unit& u, int wr, int wc, int fr, int fq) const {
        const int row0 = u.pm * BM + wr * 64 + fr;
        if (u.pn >= 2) {
            const int col0 = u.pn * BM + wc * 32 + 8 * fq;
#pragma unroll
            for (int ai = 0; ai < 2; ++ai)
#pragma unroll
                for (int m = 0; m < 4; ++m) { bf16_t* rowp = Zo + (size_t)(row0 + ai * HALF + m * 16) * NZ + col0;
#pragma unroll
                    for (int bj = 0; bj < 2; ++bj) { f32x4 v0 = acc[ai][bj][m][0], v1 = acc[ai][bj][m][1];
#pragma unroll
                        for (int e = 0; e < 4; ++e) { v0[e] = gelu_tanh(v0[e]); v1[e] = gelu_tanh(v1[e]); }
                        u32x4 w; w.x = cvt_pk_bf16(v0[0], v0[1]); w.y = cvt_pk_bf16(v0[2], v0[3]); w.z = cvt_pk_bf16(v1[0], v1[1]); w.w = cvt_pk_bf16(v1[2], v1[3]);
                        *(u32x4*)(rowp + bj * HALF) = w; } }
            return;
        }
        const bool isq = (u.pn == 0);
#pragma unroll
        for (int ai = 0; ai < 2; ++ai)
#pragma unroll
            for (int m = 0; m < 4; ++m) {
                const f32x4 a0 = acc[ai][0][m][0], a1 = acc[ai][0][m][1], b0 = acc[ai][1][m][0], b1 = acc[ai][1][m][1];
                float s = ((a0[0] * a0[0] + a0[1] * a0[1]) + (a0[2] * a0[2] + a0[3] * a0[3])) + ((a1[0] * a1[0] + a1[1] * a1[1]) + (a1[2] * a1[2] + a1[3] * a1[3]));
                if (isq) s += ((b0[0] * b0[0] + b0[1] * b0[1]) + (b0[2] * b0[2] + b0[3] * b0[3])) + ((b1[0] * b1[0] + b1[1] * b1[1]) + (b1[2] * b1[2] + b1[3] * b1[3]));
                s += __shfl_xor(s, 16); s += __shfl_xor(s, 32);
                if (fq == 0) P[(ai * HALF + wr * 64 + m * 16 + fr) * 4 + wc] = s;
            }
        asm volatile("s_waitcnt lgkmcnt(0)" ::: "memory"); __builtin_amdgcn_s_barrier(); asm volatile("" ::: "memory");
        const float invn = isq ? (1.0f / QL) : (1.0f / KVL);
        const int c8 = wc * 32 + 8 * fq;
        const float sgn = (fq < 2) ? -1.0f : 1.0f;
#pragma unroll
        for (int ai = 0; ai < 2; ++ai)
#pragma unroll
            for (int m = 0; m < 4; ++m) {
                const int rl = ai * HALF + wr * 64 + m * 16 + fr; const int row = u.pm * BM + rl;
                const float rs = rsqrtf(((P[rl * 4 + 0] + P[rl * 4 + 1]) + (P[rl * 4 + 2] + P[rl * 4 + 3])) * invn + EPS);
                if (isq) {
#pragma unroll
                    for (int bj = 0; bj < 2; ++bj) { const f32x4 g0 = *(const f32x4*)(gq + bj * HALF + c8), g1 = *(const f32x4*)(gq + bj * HALF + c8 + 4);
                        const f32x4 v0 = acc[ai][bj][m][0] * rs * g0, v1 = acc[ai][bj][m][1] * rs * g1;
                        u32x4 w; w.x = cvt_pk_bf16(v0[0], v0[1]); w.y = cvt_pk_bf16(v0[2], v0[3]); w.z = cvt_pk_bf16(v1[0], v1[1]); w.w = cvt_pk_bf16(v1[2], v1[3]);
                        *(u32x4*)(CQNo + (size_t)row * QL + bj * HALF + c8) = w; }
                } else {
                    { const f32x4 g0 = *(const f32x4*)(gkv + c8), g1 = *(const f32x4*)(gkv + c8 + 4);
                      const f32x4 v0 = acc[ai][0][m][0] * rs * g0, v1 = acc[ai][0][m][1] * rs * g1;
                      u32x4 w; w.x = cvt_pk_bf16(v0[0], v0[1]); w.y = cvt_pk_bf16(v0[2], v0[3]); w.z = cvt_pk_bf16(v1[0], v1[1]); w.w = cvt_pk_bf16(v1[2], v1[3]);
                      *(u32x4*)(CKVNo + (size_t)row * KVL + c8) = w; }
                    if (wc == 0) {
                        f32x4 v0 = acc[ai][1][m][0], v1 = acc[ai][1][m][1];
                        const float* rp = rope + (size_t)(row & (SEQ - 1)) * 32 + 16 * (fq & 1);
                        const f32x4 c0 = *(const f32x4*)rp, c1 = *(const f32x4*)(rp + 4), c2 = *(const f32x4*)(rp + 8), c3 = *(const f32x4*)(rp + 12);
                        const float cs[8] = {c0[0], c0[2], c1[0], c1[2], c2[0], c2[2], c3[0], c3[2]}, sn[8] = {c0[1], c0[3], c1[1], c1[3], c2[1], c2[3], c3[1], c3[3]};
#pragma unroll
                        for (int e = 0; e < 4; ++e) { const float o0 = __shfl_xor(v0[e], 32), o1 = __shfl_xor(v1[e], 32);
                            v0[e] = v0[e] * cs[e] + sgn * o0 * sn[e]; v1[e] = v1[e] * cs[4 + e] + sgn * o1 * sn[4 + e]; }
                        u32x4 w; w.x = cvt_pk_bf16(v0[0], v0[1]); w.y = cvt_pk_bf16(v0[2], v0[3]); w.z = cvt_pk_bf16(v1[0], v1[1]); w.w = cvt_pk_bf16(v1[2], v1[3]);
                        *(u32x4*)(KRo + (size_t)row * 32 + 8 * fq) = w;
                    }
                }
            }
    }
};
struct EpiQ {
    static constexpr bool PERM = true, AFTER_DRAIN = false, NONTRANS = false;
    bf16_t* O; const float* rope;
    __device__ __forceinline__ void operator()(const f32x4 (&acc)[2][2][4][2], const Unit& u, int wr, int wc, int fr, int fq) const {
        const int row0 = u.pm * BM + wr * 64 + fr; const int col0 = u.pn * BM + wc * 32 + 8 * fq;
        const float sgn = (fq < 2) ? -1.0f : 1.0f;
#pragma unroll
        for (int bj = 0; bj < 2; ++bj) {
            const int g32 = 8 * u.pn + 4 * bj + wc; const bool is_rope = (g32 % 3) == 2;
#pragma unroll
            for (int ai = 0; ai < 2; ++ai)
#pragma unroll
                for (int m = 0; m < 4; ++m) {
                    const int row = row0 + ai * HALF + m * 16;
                    f32x4 v0 = acc[ai][bj][m][0] * C2, v1 = acc[ai][bj][m][1] * C2;
                    if (is_rope) {
                        const float* rp = rope + (size_t)(row & (SEQ - 1)) * 32 + 16 * (fq & 1);
                        const f32x4 c0 = *(const f32x4*)rp, c1 = *(const f32x4*)(rp + 4), c2 = *(const f32x4*)(rp + 8), c3 = *(const f32x4*)(rp + 12);
                        const float cs[8] = {c0[0], c0[2], c1[0], c1[2], c2[0], c2[2], c3[0], c3[2]}, sn[8] = {c0[1], c0[3], c1[1], c1[3], c2[1], c2[3], c3[1], c3[3]};
#pragma unroll
                        for (int e = 0; e < 4; ++e) {
                            const float o0 = __shfl_xor(v0[e], 32), o1 = __shfl_xor(v1[e], 32);
                            v0[e] = v0[e] * cs[e] + sgn * o0 * sn[e]; v1[e] = v1[e] * cs[4 + e] + sgn * o1 * sn[4 + e];
                        }
                    }
                    u32x4 w; w.x = cvt_pk_bf16(v0[0], v0[1]); w.y = cvt_pk_bf16(v0[2], v0[3]); w.z = cvt_pk_bf16(v1[0], v1[1]); w.w = cvt_pk_bf16(v1[2], v1[3]);
                    *(u32x4*)(O + (size_t)row * NQ + col0 + bj * HALF) = w;
                }
        }
    }
};

struct EpiConv {
    static constexpr bool PERM = false, AFTER_DRAIN = false, NONTRANS = true;
    bf16_t* ACT; float* SIDE; const float* cw; const float* cb; PG8_LAS float* halo;
    __device__ __forceinline__ void operator()(const f32x4 (&acc)[2][2][4][2], const Unit& u, int wr, int wc, int fr, int fq) const {
        const int lane = threadIdx.x & 63;
        const int j0 = 128 * u.pn + 32 * wc + 2 * fr;
        float wa[2][3], wb[2][3], ba[2], bb[2];
        {
            f32x2_t ta[3], tb[3];
#pragma unroll
            for (int k = 0; k < 3; ++k) { ta[k] = *(const f32x2_t*)(cw + k * NUP + j0); tb[k] = *(const f32x2_t*)(cw + k * NUP + DFF + j0); }
            const f32x2_t tba = *(const f32x2_t*)(cb + j0), tbb = *(const f32x2_t*)(cb + DFF + j0);
#pragma unroll
            for (int n = 0; n < 2; ++n) {
#pragma unroll
                for (int k = 0; k < 3; ++k) { wa[n][k] = ta[k][n]; wb[n][k] = tb[k][n]; }
                ba[n] = tba[n]; bb[n] = tbb[n]; }
        }
        if (fq == 3) {
#pragma unroll
            for (int ai = 0; ai < 2; ++ai)
#pragma unroll
                for (int bj = 0; bj < 2; ++bj)
#pragma unroll
                    for (int n = 0; n < 2; ++n) { PG8_LAS float* hp = halo + (((((ai * 2 + wr) * 4 + wc) * 2 + bj) * 2 + n) * 32) + fr; hp[0] = acc[ai][bj][3][n][2]; hp[16] = acc[ai][bj][3][n][3]; }
        }
        asm volatile("s_waitcnt lgkmcnt(0)" ::: "memory"); __builtin_amdgcn_s_barrier(); asm volatile("" ::: "memory");
        const int src = ((lane - 16) & 63) * 4;
#pragma unroll
        for (int ai = 0; ai < 2; ++ai) {
            const int blk = 2 * ai + wr;
#pragma unroll
            for (int m = 0; m < 4; ++m) {
                float o[2][4];
#pragma unroll
                for (int n = 0; n < 2; ++n) {
                    const f32x4 Xa = acc[ai][0][m][n], Xb = acc[ai][1][m][n];
                    float da2, da3, db2, db3;
                    if (m > 0) { const bool t = (fq == 3); da2 = t ? acc[ai][0][m > 0 ? m - 1 : 0][n][2] : Xa[2]; da3 = t ? acc[ai][0][m > 0 ? m - 1 : 0][n][3] : Xa[3];
                                 db2 = t ? acc[ai][1][m > 0 ? m - 1 : 0][n][2] : Xb[2]; db3 = t ? acc[ai][1][m > 0 ? m - 1 : 0][n][3] : Xb[3]; }
                    else { da2 = Xa[2]; da3 = Xa[3]; db2 = Xb[2]; db3 = Xb[3]; }
                    float Ha2 = __builtin_bit_cast(float, __builtin_amdgcn_ds_bpermute(src, __builtin_bit_cast(int, da2)));
                    float Ha3 = __builtin_bit_cast(float, __builtin_amdgcn_ds_bpermute(src, __builtin_bit_cast(int, da3)));
                    float Hb2 = __builtin_bit_cast(float, __builtin_amdgcn_ds_bpermute(src, __builtin_bit_cast(int, db2)));
                    float Hb3 = __builtin_bit_cast(float, __builtin_amdgcn_ds_bpermute(src, __builtin_bit_cast(int, db3)));
                    if (m == 0) {
                        float h2a = 0.f, h3a = 0.f, h2b = 0.f, h3b = 0.f;
                        if (blk > 0) { const PG8_LAS float* hp = halo + ((((blk - 1) * 4 + wc) * 2 + 0) * 2 + n) * 32 + fr; h2a = hp[0]; h3a = hp[16]; h2b = hp[64]; h3b = hp[80]; }
                        if (fq == 0) { Ha2 = h2a; Ha3 = h3a; Hb2 = h2b; Hb3 = h3b; }
                    }
                    const f32x2_t W0 = {wa[n][0], wb[n][0]}, W1 = {wa[n][1], wb[n][1]}, W2 = {wa[n][2], wb[n][2]}, B2 = {ba[n], bb[n]};
                    const f32x2_t H2 = {Ha2, Hb2}, H3 = {Ha3, Hb3}, X0 = {Xa[0], Xb[0]}, X1 = {Xa[1], Xb[1]}, X2 = {Xa[2], Xb[2]}, X3 = {Xa[3], Xb[3]};
                    const f32x2_t y0 = B2 + W0 * H2 + W1 * H3 + W2 * X0, y1 = B2 + W0 * H3 + W1 * X0 + W2 * X1, y2 = B2 + W0 * X0 + W1 * X1 + W2 * X2, y3 = B2 + W0 * X1 + W1 * X2 + W2 * X3;
                    const float ya0 = y0[0], yb0 = y0[1], ya1 = y1[0], yb1 = y1[1], ya2 = y2[0], yb2 = y2[1], ya3 = y3[0], yb3 = y3[1];
                    o[n][0] = silu_f(ya0) * yb0; o[n][1] = silu_f(ya1) * yb1; o[n][2] = silu_f(ya2) * yb2; o[n][3] = silu_f(ya3) * yb3;
                    if (blk == 0 && m == 0 && fq == 0) { float* sp = SIDE + ((size_t)(u.pm * 4 + 0) * 2) * DFF + j0 + n; sp[0] = Xa[0]; sp[DFF] = Xb[0]; sp[2 * DFF] = Xa[1]; sp[3 * DFF] = Xb[1]; }
                    if (blk == 3 && m == 3 && fq == 3) { float* sp = SIDE + ((size_t)(u.pm * 4 + 2) * 2) * DFF + j0 + n; sp[0] = Xa[2]; sp[DFF] = Xb[2]; sp[2 * DFF] = Xa[3]; sp[3 * DFF] = Xb[3]; }
                }
                bf16_t* op = ACT + (size_t)(u.pm * BM + ai * HALF + wr * 64 + m * 16 + 4 * fq) * DFF + j0;
#pragma unroll
                for (int e = 0; e < 4; ++e) *(unsigned*)(op + (size_t)e * DFF) = cvt_pk_bf16(o[0][e], o[1][e]);
            }
        }
    }
};

struct PanelSS {
    float* xbuf; unsigned* cnt; int pm_off; float eps;
    __device__ __forceinline__ void run(const f32x4 (&v)[2][2][4][2], const Unit& u, int wr, int wc, int fr, int fq, PG8_LAS unsigned char* lds, int wid, int lane) const {
        PG8_LAS float* P = (PG8_LAS float*)lds; PG8_LAS float* S = (PG8_LAS float*)(lds + 4096);
        const int pmg = u.pm + pm_off;
#pragma unroll
        for (int ai = 0; ai < 2; ++ai)
#pragma unroll
            for (int m = 0; m < 4; ++m) {
                float s = 0.f;
#pragma unroll
                for (int bj = 0; bj < 2; ++bj)
#pragma unroll
                    for (int n = 0; n < 2; ++n) { const f32x4 x = v[ai][bj][m][n]; s += (x[0] * x[0] + x[1] * x[1]) + (x[2] * x[2] + x[3] * x[3]); }
                s += __shfl_xor(s, 16); s += __shfl_xor(s, 32);
                if (fq == 0) P[(ai * HALF + wr * 64 + m * 16 + fr) * 4 + wc] = s;
            }
        asm volatile("s_waitcnt lgkmcnt(0)" ::: "memory"); __builtin_amdgcn_s_barrier(); asm volatile("" ::: "memory");
        const int row = wid * 32 + (lane & 31);
        if (lane < 32) {
            const float tot = (P[row * 4 + 0] + P[row * 4 + 1]) + (P[row * 4 + 2] + P[row * 4 + 3]);
            __hip_atomic_store(xbuf + ((size_t)(pmg * BM + row) * 4 + u.pn), tot, __ATOMIC_RELAXED, __HIP_MEMORY_SCOPE_AGENT);
        }
        asm volatile("s_waitcnt vmcnt(0)" ::: "memory");
        if (lane == 0) __hip_atomic_fetch_add(cnt + 64 * pmg, 1u, __ATOMIC_RELAXED, __HIP_MEMORY_SCOPE_AGENT);
        if (wid == 0) {
            unsigned sp = 0;
            while ((unsigned)__builtin_amdgcn_readfirstlane(__hip_atomic_load(cnt + 64 * pmg, __ATOMIC_RELAXED, __HIP_MEMORY_SCOPE_AGENT)) < 32u) { __builtin_amdgcn_s_sleep(2); if (++sp > (1u << 22)) break; }
            __builtin_amdgcn_fence(__ATOMIC_ACQUIRE, "agent");
        }
        asm volatile("s_waitcnt vmcnt(0) lgkmcnt(0)" ::: "memory"); __builtin_amdgcn_s_barrier(); asm volatile("" ::: "memory");
        if (lane < 32) {
            const float* slot = xbuf + (size_t)(pmg * BM + row) * 4; float t = 0.f;
#pragma unroll
            for (int k = 0; k < 4; ++k) t += __hip_atomic_load(slot + k, __ATOMIC_RELAXED, __HIP_MEMORY_SCOPE_AGENT);
            S[row] = rsqrtf(t * (1.0f / 1024.0f) + eps);
        }
        asm volatile("s_waitcnt lgkmcnt(0)" ::: "memory"); __builtin_amdgcn_s_barrier(); asm volatile("" ::: "memory");
    }
};
struct EpiRmsRes {
    static constexpr bool PERM = false, AFTER_DRAIN = true, NONTRANS = false;
    const float* base; float* out; const float* gv; int row_off; PanelSS st;
    __device__ __forceinline__ void fused(f32x4 (&acc)[2][2][4][2], const Unit& u, int wr, int wc, int fr, int fq, PG8_LAS unsigned char* lds, int wid, int lane) const {
        const PG8_LAS float* S = (const PG8_LAS float*)(lds + 4096);
        const int col0 = u.pn * BM + wc * 32 + 4 * fq;
        st.run(acc, u, wr, wc, fr, fq, lds, wid, lane);
        f32x4 g[2][2];
#pragma unroll
        for (int bj = 0; bj < 2; ++bj)
#pragma unroll
            for (int n = 0; n < 2; ++n) g[bj][n] = *(const f32x4*)(gv + col0 + bj * HALF + n * 16);
#pragma unroll
        for (int ai = 0; ai < 2; ++ai)
#pragma unroll
            for (int m = 0; m < 4; ++m) { const int r = ai * HALF + wr * 64 + m * 16 + fr; const float rs = S[r]; const size_t off = (size_t)(row_off + u.pm * BM + r) * DM + col0;
#pragma unroll
                for (int bj = 0; bj < 2; ++bj)
#pragma unroll
                    for (int n = 0; n < 2; ++n) { const f32x4 bs = *(const f32x4*)(base + off + bj * HALF + n * 16); __builtin_nontemporal_store(bs + acc[ai][bj][m][n] * rs * g[bj][n], (f32x4*)(out + off + bj * HALF + n * 16)); }
                if (m & 1) asm volatile("" ::: "memory"); }
        asm volatile("s_waitcnt lgkmcnt(0)" ::: "memory"); __builtin_amdgcn_s_barrier(); asm volatile("" ::: "memory");
    }
};

struct EpiRmsResRms {
    static constexpr bool PERM = false, AFTER_DRAIN = true, NONTRANS = false;
    const float* base; float* out; bf16_t* xn; const float* gv1; const float* gv2; const float* sv2; int row_off; PanelSS st1, st2;
    __device__ __forceinline__ void fused(f32x4 (&acc)[2][2][4][2], const Unit& u, int wr, int wc, int fr, int fq, PG8_LAS unsigned char* lds, int wid, int lane) const {
        const PG8_LAS float* S = (const PG8_LAS float*)(lds + 4096);
        const int col0 = u.pn * BM + wc * 32 + 4 * fq;
        st1.run(acc, u, wr, wc, fr, fq, lds, wid, lane);
        {
            f32x4 g[2][2];
#pragma unroll
            for (int bj = 0; bj < 2; ++bj)
#pragma unroll
                for (int n = 0; n < 2; ++n) g[bj][n] = *(const f32x4*)(gv1 + col0 + bj * HALF + n * 16);
#pragma unroll
            for (int ai = 0; ai < 2; ++ai)
#pragma unroll
                for (int m = 0; m < 4; ++m) { const int r = ai * HALF + wr * 64 + m * 16 + fr; const float rs = S[r]; const size_t off = (size_t)(row_off + u.pm * BM + r) * DM + col0;
#pragma unroll
                    for (int bj = 0; bj < 2; ++bj)
#pragma unroll
                        for (int n = 0; n < 2; ++n) { const f32x4 bs = __builtin_nontemporal_load((const f32x4*)(base + off + bj * HALF + n * 16)); acc[ai][bj][m][n] = bs + acc[ai][bj][m][n] * rs * g[bj][n]; }
                    asm volatile("" : "+v"(acc[ai][0][m][0]), "+v"(acc[ai][0][m][1]), "+v"(acc[ai][1][m][0]), "+v"(acc[ai][1][m][1]));
                    if (m & 1) asm volatile("" ::: "memory"); }
        }
        st2.run(acc, u, wr, wc, fr, fq, lds, wid, lane);
        {
            f32x4 g[2][2], sv[2][2];
#pragma unroll
            for (int bj = 0; bj < 2; ++bj)
#pragma unroll
                for (int n = 0; n < 2; ++n) { g[bj][n] = *(const f32x4*)(gv2 + col0 + bj * HALF + n * 16); sv[bj][n] = *(const f32x4*)(sv2 + col0 + bj * HALF + n * 16); }
#pragma unroll
            for (int ai = 0; ai < 2; ++ai)
#pragma unroll
                for (int m = 0; m < 4; ++m) { const int r = ai * HALF + wr * 64 + m * 16 + fr; const float rs = S[r]; const size_t off = (size_t)(row_off + u.pm * BM + r) * DM + col0;
#pragma unroll
                    for (int bj = 0; bj < 2; ++bj)
#pragma unroll
                        for (int n = 0; n < 2; ++n) { const f32x4 x1 = acc[ai][bj][m][n]; *(f32x4*)(out + off + bj * HALF + n * 16) = x1;
                            const f32x4 o = x1 * rs * g[bj][n] + sv[bj][n]; u32x2 w; w.x = cvt_pk_bf16(o[0], o[1]); w.y = cvt_pk_bf16(o[2], o[3]); *(u32x2*)(xn + off + bj * HALF + n * 16) = w; }
                    asm volatile("" ::: "memory"); }
        }
        asm volatile("s_waitcnt lgkmcnt(0)" ::: "memory"); __builtin_amdgcn_s_barrier(); asm volatile("" ::: "memory");
    }
};

template <class Epi, class Sched, bool ALIGN_EPI = false, bool SP2 = false>
__device__ __forceinline__ void gemm_phase(PG8_LAS unsigned char* lds, const Gemm g, const Sched& S, const Epi& E) {
    int tid_ = threadIdx.x; asm volatile("" : "+v"(tid_));
    const int tid = tid_, wid = __builtin_amdgcn_readfirstlane(tid >> 6), lane = tid & 63, wr = wid >> 2, wc = wid & 3, fr = lane & 15, fq = lane >> 4;
    const int K = g.K, nt = K / BK;
    unsigned voffA[2], voffB[2];
#pragma unroll
    for (int i = 0; i < 2; ++i) { int R, C; stage_rc(tid * 16 + i * 8192, R, C); const int Rb = Epi::PERM ? ((R & ~31) + perm32(R & 31)) : R;
        voffA[i] = (unsigned)(R * K + C) * 2u; voffB[i] = (unsigned)(Rb * K + C) * 2u; }
    const size_t kstep = (size_t)(BK * 2);
    const size_t hstep = (size_t)HALF * K * 2;
    const size_t tstep = 2 * hstep;
    const unsigned ldsw = (unsigned)wid * 1024u;
    const int aoff = lds_byte(wr * 64 + fr, fq * 8), boff = lds_byte(wc * 32 + fr, fq * 8);
#define PG8_SA(b, h) (((b) * 2 + (h)) * HTB)
#define PG8_SB(b, h) ((4 + (b) * 2 + (h)) * HTB)
#define PG8_STAGE(bufoff, gbase, voff) do { _Pragma("unroll") for (int _i = 0; _i < 2; ++_i) \
        __builtin_amdgcn_global_load_lds((const unsigned*)((const char*)(gbase) + (voff)[_i]), (PG8_LAS unsigned*)(lds + (bufoff) + ldsw + _i * 8192), 16, 0, 0); } while (0)
#define PG8_LDA(dst, b, h) do { _Pragma("unroll") for (int m = 0; m < 4; ++m) _Pragma("unroll") for (int k = 0; k < 2; ++k) dst[m][k] = *(const PG8_LAS bf16x8*)(lds + PG8_SA(b, h) + aoff + m * 2048 + k * 1024); } while (0)
#define PG8_LDB(dst, b, h) do { _Pragma("unroll") for (int n = 0; n < 2; ++n) _Pragma("unroll") for (int k = 0; k < 2; ++k) dst[n][k] = *(const PG8_LAS bf16x8*)(lds + PG8_SB(b, h) + boff + n * 2048 + k * 1024); } while (0)
#define PG8_MMA(ai, bj, At, Bt) do { __builtin_amdgcn_s_setprio(1); _Pragma("unroll") for (int m = 0; m < 4; ++m) _Pragma("unroll") for (int n = 0; n < 2; ++n) _Pragma("unroll") for (int k = 0; k < 2; ++k) \
        acc[ai][bj][m][n] = Epi::NONTRANS ? __builtin_amdgcn_mfma_f32_16x16x32_bf16(At[m][k], Bt[n][k], acc[ai][bj][m][n], 0, 0, 0) : __builtin_amdgcn_mfma_f32_16x16x32_bf16(Bt[n][k], At[m][k], acc[ai][bj][m][n], 0, 0, 0); __builtin_amdgcn_s_setprio(0); } while (0)
#define PG8_WAIT_V(n) asm volatile("s_waitcnt vmcnt(" #n ")" ::: "memory")
#define PG8_WAIT_L(n) asm volatile("s_waitcnt lgkmcnt(" #n ")" ::: "memory")
#define PG8_BAR __builtin_amdgcn_s_barrier()
#define PG8_SCHED __builtin_amdgcn_sched_barrier(0)
    Unit cur, nxt; int ui = 0;
    if (!S.next(0, cur)) return;
    f32x4 acc[2][2][4][2];
#pragma unroll
    for (int a = 0; a < 2; ++a)
#pragma unroll
        for (int b = 0; b < 2; ++b)
#pragma unroll
            for (int m = 0; m < 4; ++m)
#pragma unroll
                for (int n = 0; n < 2; ++n) acc[a][b][m][n] = (f32x4){0.f, 0.f, 0.f, 0.f};
    bf16x8 At[4][2], B0[2][2], B1[2][2];
    const char* cA = (const char*)g.A + (size_t)cur.pm * tstep; const char* cB = (const char*)g.Bt + (size_t)cur.pn * tstep;
    S.a_ready(cur);
    if constexpr (SP2) {
        PG8_STAGE(PG8_SB(0, 0), cB, voffB); PG8_STAGE(PG8_SB(0, 1), cB + hstep, voffB); PG8_STAGE(PG8_SA(0, 0), cA, voffA); PG8_STAGE(PG8_SA(0, 1), cA + hstep, voffA);
        if (wr == 1) PG8_BAR;
        PG8_WAIT_V(2); PG8_BAR;
        PG8_STAGE(PG8_SB(1, 0), cB + kstep, voffB); PG8_STAGE(PG8_SA(1, 0), cA + kstep, voffA); PG8_STAGE(PG8_SB(1, 1), cB + hstep + kstep, voffB);
        PG8_WAIT_V(6); PG8_BAR;
    } else {
        PG8_STAGE(PG8_SB(0, 0), cB, voffB); PG8_STAGE(PG8_SA(0, 0), cA, voffA); PG8_STAGE(PG8_SB(0, 1), cB + hstep, voffB); PG8_STAGE(PG8_SA(0, 1), cA + hstep, voffA);
        if (wr == 1) PG8_BAR;
        PG8_WAIT_V(4); PG8_BAR;
        PG8_STAGE(PG8_SB(1, 0), cB + kstep, voffB); PG8_STAGE(PG8_SA(1, 0), cA + kstep, voffA); PG8_STAGE(PG8_SB(1, 1), cB + hstep + kstep, voffB);
        PG8_WAIT_V(6); PG8_BAR;
    }
    for (;;) {
        const bool has_next = S.next(ui + 1, nxt);
        const char* nA = has_next ? (const char*)g.A + (size_t)nxt.pm * tstep : cA; const char* nB = has_next ? (const char*)g.Bt + (size_t)nxt.pn * tstep : cB;
        for (int t = 0; t < nt; t += 2) {
            const bool last = (t == nt - 2);
            const char* a1 = cA + (size_t)(t + 1) * kstep;
            const char* a2 = last ? nA : cA + (size_t)(t + 2) * kstep; const char* b2 = last ? nB : cB + (size_t)(t + 2) * kstep;
            const char* a3 = a2 + kstep; const char* b3 = b2 + kstep;
            if (last && has_next) S.a_ready(nxt);
            if constexpr (SP2) {
            PG8_LDB(B0, 0, 0); PG8_LDB(B1, 0, 1); PG8_SCHED; PG8_LDA(At, 0, 0); PG8_STAGE(PG8_SA(1, 1), a1 + hstep, voffA);
            PG8_WAIT_V(8); PG8_WAIT_L(0); PG8_BAR; PG8_MMA(0, 0, At, B0); PG8_MMA(0, 1, At, B1); PG8_BAR; PG8_SCHED;
            PG8_LDA(At, 0, 1); PG8_STAGE(PG8_SB(0, 0), b2, voffB); PG8_STAGE(PG8_SB(0, 1), b2 + hstep, voffB); PG8_STAGE(PG8_SA(0, 0), a2, voffA);
            PG8_WAIT_V(8); PG8_WAIT_L(0); PG8_BAR; PG8_MMA(1, 0, At, B0); PG8_MMA(1, 1, At, B1); PG8_BAR; PG8_SCHED;
            PG8_LDB(B0, 1, 0); PG8_LDB(B1, 1, 1); PG8_SCHED; PG8_LDA(At, 1, 0); PG8_STAGE(PG8_SA(0, 1), a2 + hstep, voffA);
            PG8_WAIT_V(8); PG8_WAIT_L(0); PG8_BAR; PG8_MMA(0, 0, At, B0); PG8_MMA(0, 1, At, B1); PG8_BAR; PG8_SCHED;
            PG8_LDA(At, 1, 1); PG8_STAGE(PG8_SB(1, 0), b3, voffB); PG8_STAGE(PG8_SB(1, 1), b3 + hstep, voffB); PG8_STAGE(PG8_SA(1, 0), a3, voffA);
            PG8_WAIT_V(8); PG8_WAIT_L(0); PG8_BAR; PG8_MMA(1, 0, At, B0); PG8_MMA(1, 1, At, B1); PG8_BAR; PG8_SCHED;
            } else {
            PG8_LDB(B0, 0, 0); PG8_SCHED; PG8_LDA(At, 0, 0); PG8_STAGE(PG8_SA(1, 1), a1 + hstep, voffA);
            PG8_WAIT_L(8); PG8_BAR; PG8_WAIT_L(0); PG8_MMA(0, 0, At, B0); PG8_BAR; PG8_SCHED;
            PG8_LDB(B1, 0, 1); PG8_STAGE(PG8_SB(0, 0), b2, voffB);
            PG8_BAR; PG8_WAIT_L(0); PG8_MMA(0, 1, At, B1); PG8_BAR;
            PG8_LDA(At, 0, 1); PG8_STAGE(PG8_SA(0, 0), a2, voffA);
            PG8_BAR; PG8_WAIT_L(0); PG8_MMA(1, 0, At, B0); PG8_BAR; PG8_SCHED;
            PG8_STAGE(PG8_SB(0, 1), b2 + hstep, voffB);
            PG8_WAIT_V(6); PG8_BAR; PG8_MMA(1, 1, At, B1); PG8_BAR;
            PG8_LDB(B0, 1, 0); PG8_SCHED; PG8_LDA(At, 1, 0); PG8_STAGE(PG8_SA(0, 1), a2 + hstep, voffA);
            PG8_WAIT_L(8); PG8_BAR; PG8_WAIT_L(0); PG8_MMA(0, 0, At, B0); PG8_BAR; PG8_SCHED;
            PG8_LDB(B1, 1, 1); PG8_STAGE(PG8_SB(1, 0), b3, voffB);
            PG8_BAR; PG8_WAIT_L(0); PG8_MMA(0, 1, At, B1); PG8_BAR;
            PG8_LDA(At, 1, 1); PG8_STAGE(PG8_SA(1, 0), a3, voffA);
            PG8_BAR; PG8_WAIT_L(0); PG8_MMA(1, 0, At, B0); PG8_BAR; PG8_SCHED;
            PG8_STAGE(PG8_SB(1, 1), b3 + hstep, voffB);
            PG8_WAIT_V(6); PG8_BAR; PG8_MMA(1, 1, At, B1); PG8_BAR;
            }
        }
        if constexpr (ALIGN_EPI) { if (wr == 0) PG8_BAR; }
        if constexpr (!Epi::AFTER_DRAIN) { E(acc, cur, wr, wc, fr, fq); S.done(cur); }
        if (!has_next) break;
#pragma unroll
        for (int a = 0; a < 2; ++a)
#pragma unroll
            for (int b = 0; b < 2; ++b)
#pragma unroll
                for (int m = 0; m < 4; ++m)
#pragma unroll
                    for (int n = 0; n < 2; ++n) acc[a][b][m][n] = (f32x4){0.f, 0.f, 0.f, 0.f};
        cur = nxt; cA = nA; cB = nB; ++ui;
        if constexpr (ALIGN_EPI) { if (wr == 1) PG8_BAR; }
    }
    PG8_WAIT_V(0);
    if constexpr (!ALIGN_EPI) { if (wr == 0) PG8_BAR; }
    PG8_BAR;
    if constexpr (Epi::AFTER_DRAIN) { E.fused(acc, cur, wr, wc, fr, fq, lds, wid, lane); S.done(cur); }
#undef PG8_SA
#undef PG8_SB
#undef PG8_STAGE
#undef PG8_LDA
#undef PG8_LDB
#undef PG8_MMA
#undef PG8_WAIT_V
#undef PG8_WAIT_L
#undef PG8_BAR
#undef PG8_SCHED
}
}
#define XB_TMO      128
#define XB_XCNT(j)  (256  + 64 * (j))
#define XB_XSUB(j)  (1280 + 64 * (j))
#define XB_XGEN(j)  (2304 + 64 * (j))
#define XB_TOP      3328
#define XB_TOPGEN   3392
#define XCD_BAR_WORDS 3456
#define XB_SPIN_CAP (1u << 18)

__device__ __forceinline__ unsigned xb_ld(unsigned* p)              { return __hip_atomic_load(p, __ATOMIC_RELAXED, __HIP_MEMORY_SCOPE_AGENT); }
__device__ __forceinline__ unsigned xb_add(unsigned* p, unsigned v) { return __hip_atomic_fetch_add(p, v, __ATOMIC_RELAXED, __HIP_MEMORY_SCOPE_AGENT); }
__device__ __forceinline__ unsigned xb_xcc_id() { return (unsigned)__builtin_amdgcn_s_getreg((3 << 11) | 20) & 0xFu; }
#define XB_SPIN(cond, bar) do { unsigned _sp = 0; while (cond) { __builtin_amdgcn_s_sleep(1); \
    if ((++_sp & 255u) == 0u) { if (xb_ld(&(bar)[XB_TMO])) break; if (_sp > XB_SPIN_CAP) { atomicAdd(&(bar)[XB_TMO], 1u); break; } } } } while (0)

struct XcdBarrier {
    unsigned* bar; unsigned x;
    volatile LAS unsigned* st;
};

__device__ __forceinline__ XcdBarrier xcd_barrier_post(unsigned* bar, volatile LAS unsigned* st) {
    XcdBarrier b; b.bar = bar; b.x = xb_xcc_id(); b.st = st;
    if (threadIdx.x == 0) (void)xb_add(&bar[XB_XCNT(b.x)], 1u);
    return b;
}
__device__ __forceinline__ void xcd_barrier_complete(unsigned* bar, unsigned x, unsigned& nloc, unsigned& nx) {
    const unsigned G = gridDim.x * gridDim.y * gridDim.z;
    unsigned sum, cnt, mine, sp = 0u;
    for (;;) {
        sum = 0u; cnt = 0u; mine = 0u;
#pragma unroll 1
        for (unsigned j = 0; j < 16; ++j) { const unsigned c = xb_ld(&bar[XB_XCNT(j)]); sum += c; cnt += (c > 0u) ? 1u : 0u; mine = (j == x) ? c : mine; }
        if (sum == G) break;
        __builtin_amdgcn_s_sleep(1);
        if ((++sp & 255u) == 0u) { if (xb_ld(&bar[XB_TMO])) break; if (sp > XB_SPIN_CAP) { atomicAdd(&bar[XB_TMO], 1u); break; } }
    }
    nloc = mine > 0u ? mine : 1u; nx = cnt > 0u ? cnt : 1u;
}

__device__ __forceinline__ void xcd_barrier(const XcdBarrier& b) {
    asm volatile("s_waitcnt vmcnt(0)" ::: "memory");
    __syncthreads();
    if (threadIdx.x == 0) {
        unsigned* bar = b.bar;
        __builtin_amdgcn_s_waitcnt(0);
        unsigned nloc = b.st[0], nx = b.st[1];
        if (nloc == 0u) { xcd_barrier_complete(bar, b.x, nloc, nx); b.st[0] = nloc; b.st[1] = nx; }
        const unsigned old = xb_add(&bar[XB_XSUB(b.x)], 1u);
        const unsigned gen = old / nloc;
        if (old + 1u == (gen + 1u) * nloc) {
            __builtin_amdgcn_fence(__ATOMIC_RELEASE, "agent");
            asm volatile("s_waitcnt vmcnt(0)" ::: "memory");
            const unsigned og = xb_add(&bar[XB_TOP], 1u);
            const unsigned tg = og / nx;
            if (og + 1u == (tg + 1u) * nx) xb_add(&bar[XB_TOPGEN], 1u);
            else XB_SPIN(xb_ld(&bar[XB_TOPGEN]) == tg, bar);
            __builtin_amdgcn_fence(__ATOMIC_ACQUIRE, "agent");
            xb_add(&bar[XB_XGEN(b.x)], 1u);
            asm volatile("s_waitcnt vmcnt(0)" ::: "memory");
        } else {
            XB_SPIN(xb_ld(&bar[XB_XGEN(b.x)]) == gen, bar);
            __builtin_amdgcn_fence(__ATOMIC_ACQUIRE, "agent");
            asm volatile("s_waitcnt vmcnt(0)" ::: "memory");
        }
    }
    __syncthreads();
}

__device__ __forceinline__ void tr_item(const float* __restrict__ W, int K, int N, bf16_t* WT, int k0, int n0, int drow0, LAS float* scr, int lane, bool perm = false) {
    { f32x4 v[8];
#pragma unroll
      for (int i = 0; i < 8; ++i) { const int ch = i * 64 + lane, kk = ch >> 3, c4 = ch & 7; v[i] = __builtin_nontemporal_load((const f32x4*)(W + (size_t)(k0 + kk) * N + n0 + 4 * c4)); }
#pragma unroll
      for (int i = 0; i < 8; ++i) { const int ch = i * 64 + lane, kk = ch >> 3, c4 = ch & 7; LAS float* d = scr + kk * 33 + 4 * c4; d[0] = v[i][0]; d[1] = v[i][1]; d[2] = v[i][2]; d[3] = v[i][3]; } }
    asm volatile("s_waitcnt lgkmcnt(0)" ::: "memory");
    const int c = lane & 7;
#pragma unroll
    for (int j = 0; j < 4; ++j) { const int n = (lane >> 3) + 8 * j; const LAS float* s = scr + (8 * c) * 33 + n;
        u32x4 o; o.x = pk2(s[0 * 33], s[1 * 33]); o.y = pk2(s[2 * 33], s[3 * 33]); o.z = pk2(s[4 * 33], s[5 * 33]); o.w = pk2(s[6 * 33], s[7 * 33]);
        *(u32x4*)(WT + (size_t)(drow0 + (perm ? 16 * (n & 1) + (n >> 1) : n)) * K + k0 + 8 * c) = o; }
    asm volatile("s_waitcnt lgkmcnt(0)" ::: "memory");
}

typedef float f32x2v __attribute__((ext_vector_type(2)));
__device__ __forceinline__ float max3f(float a, float b, float c) { return fmaxf(fmaxf(a, b), c); }
__device__ __forceinline__ void attn_ldk(bf16x8 (&kf)[12], const LAS unsigned char* kb) {
    constexpr int KP = 104;
#pragma unroll
    for (int ks = 0; ks < 6; ++ks) { kf[2 * ks] = *(const LAS bf16x8*)(kb + 32 * ks); kf[2 * ks + 1] = *(const LAS bf16x8*)(kb + 32 * KP * 2 + 32 * ks); }
}
__device__ __forceinline__ void attn_ldv(bf16x8 (&vf)[8], const LAS unsigned char* vb) {
    constexpr int VP = 136;
#pragma unroll
    for (int s = 0; s < 4; ++s) { vf[2 * s] = *(const LAS bf16x8*)(vb + 32 * s); vf[2 * s + 1] = *(const LAS bf16x8*)(vb + 32 * VP * 2 + 32 * s); }
}
__device__ __forceinline__ void attn_qk(f32x16& p0, f32x16& p1, const bf16x8 (&kf)[12], const bf16x8 (&qf)[6]) {
    const f32x16 zero = {0.f, 0.f, 0.f, 0.f, 0.f, 0.f, 0.f, 0.f, 0.f, 0.f, 0.f, 0.f, 0.f, 0.f, 0.f, 0.f};
#pragma unroll
    for (int ks = 0; ks < 6; ++ks) {
        p0 = __builtin_amdgcn_mfma_f32_32x32x16_bf16(kf[2 * ks], qf[ks], ks == 0 ? zero : p0, 0, 0, 0);
        p1 = __builtin_amdgcn_mfma_f32_32x32x16_bf16(kf[2 * ks + 1], qf[ks], ks == 0 ? zero : p1, 0, 0, 0);
    }
}
__device__ __forceinline__ void attn_softmax(f32x16& p0, f32x16& p1, bf16x8 (&pb)[4], f32x16& o0, f32x16& o1, float& m_run, float& l_run) {
    float mx = max3f(p0[0], p0[1], p1[0]), my = max3f(p0[2], p0[3], p1[1]);
    mx = max3f(mx, p1[2], p1[3]);
#pragma unroll
    for (int r = 4; r < 16; r += 4) { mx = max3f(mx, p0[r], p0[r + 1]); my = max3f(my, p0[r + 2], p0[r + 3]); mx = max3f(mx, p1[r], p1[r + 1]); my = max3f(my, p1[r + 2], p1[r + 3]); }
    mx = fmaxf(mx, my);
    { auto rr = __builtin_amdgcn_permlane32_swap(__float_as_uint(mx), __float_as_uint(mx), false, false); mx = fmaxf(__uint_as_float(rr[0]), __uint_as_float(rr[1])); }
    const float m_new = fmaxf(m_run, mx);
    const float alpha = __builtin_amdgcn_exp2f(m_run - m_new);
    m_run = m_new;
    p0 = p0 - m_new; p1 = p1 - m_new;
#pragma unroll
    for (int r = 0; r < 16; ++r) { p0[r] = __builtin_amdgcn_exp2f(p0[r]); p1[r] = __builtin_amdgcn_exp2f(p1[r]); }
    f32x16 sm = p0 + p1;
    f32x2v s2 = (f32x2v){sm[0], sm[1]} + (f32x2v){sm[2], sm[3]};
#pragma unroll
    for (int r = 4; r < 16; r += 2) s2 += (f32x2v){sm[r], sm[r + 1]};
    l_run = l_run * alpha + (s2[0] + s2[1]);
    o0 = o0 * alpha; o1 = o1 * alpha;
#pragma unroll
    for (int s = 0; s < 2; ++s) {
        u32x4 w; w.x = pk2(p0[8 * s], p0[8 * s + 1]); w.y = pk2(p0[8 * s + 2], p0[8 * s + 3]); w.z = pk2(p0[8 * s + 4], p0[8 * s + 5]); w.w = pk2(p0[8 * s + 6], p0[8 * s + 7]);
        pb[s] = __builtin_bit_cast(bf16x8, w);
        u32x4 w2; w2.x = pk2(p1[8 * s], p1[8 * s + 1]); w2.y = pk2(p1[8 * s + 2], p1[8 * s + 3]); w2.z = pk2(p1[8 * s + 4], p1[8 * s + 5]); w2.w = pk2(p1[8 * s + 6], p1[8 * s + 7]);
        pb[2 + s] = __builtin_bit_cast(bf16x8, w2);
    }
}
__device__ __forceinline__ void attn_pv(const bf16x8 (&vf)[8], const bf16x8 (&pb)[4], f32x16& o0, f32x16& o1) {
#pragma unroll
    for (int s = 0; s < 4; ++s) {
        o0 = __builtin_amdgcn_mfma_f32_32x32x16_bf16(vf[2 * s], pb[s], o0, 0, 0, 0);
        o1 = __builtin_amdgcn_mfma_f32_32x32x16_bf16(vf[2 * s + 1], pb[s], o1, 0, 0, 0);
    }
}
__device__ __forceinline__ void attn_phase(LAS unsigned char* lds, const bf16_t* __restrict__ Q, const bf16_t* __restrict__ KN, const bf16_t* __restrict__ KR,
                                           const bf16_t* __restrict__ VT, bf16_t* AO, int vcu, int G, int tid, int lane, int wave) {
    constexpr int KP = 104, VP = 136, KBUF = 128 * KP * 2, VBUF = 64 * VP * 2, BUF = KBUF + VBUF;
    if (wave >= 4) __builtin_amdgcn_s_setprio(1);
    const int r32 = lane & 31, hi = lane >> 5;
    const int pr = (r32 & ~12) | ((r32 & 4) << 1) | ((r32 & 8) >> 1);
    const int key_l = tid >> 3, kc = tid & 7, key_r = tid >> 2, rc = tid & 3, vd = tid >> 3, vc = tid & 7;
    for (int p = vcu; p < 512; p += G) {
#pragma unroll 1
        for (int half = 0; half < 2; ++half) {
            const int bh = p >> 3, pp = p & 7, qb = half ? 15 - pp : pp, b = bh >> 3, h = bh & 7;
            const size_t rowbase = (size_t)b * SEQ;
            const int qrow0 = qb * 256 + wave * 32, qc = qrow0 >> 6, NT2 = 2 * qb + 2;
            bf16x8 qf[6];
            { const bf16_t* qp = Q + (rowbase + qrow0 + r32) * NQ + h * 96 + 8 * hi;
#pragma unroll
              for (int ks = 0; ks < 6; ++ks) qf[ks] = *(const bf16x8*)(qp + 16 * ks); }
            const char* kbase = (const char*)(KN + rowbase * NKN + h * 64); const unsigned koff = (unsigned)(key_l * NKN + 8 * kc) * 2u;
            const char* rbase = (const char*)(KR + rowbase * 32); const unsigned roff = (unsigned)(key_r * 32 + 8 * rc) * 2u;
            const char* vbase = (const char*)(VT + (size_t)(h * 64) * MTOK + rowbase); const unsigned voff = (unsigned)((size_t)vd * MTOK + 8 * vc) * 2u;
            const int kdst = (key_l * KP + 8 * kc) * 2, rdst = (key_r * KP + 64 + 8 * rc) * 2, vdst = KBUF + (vd * VP + 8 * vc) * 2;
            u32x4 gk0, gk1, gr, gv0, gv1;
            gk0 = *(const u32x4*)(kbase + koff); gk1 = *(const u32x4*)(kbase + 64 * NKN * 2 + koff); gr = *(const u32x4*)(rbase + roff); gv0 = *(const u32x4*)(vbase + voff); gv1 = *(const u32x4*)(vbase + 128 + voff);
            *(LAS u32x4*)(lds + kdst) = gk0; *(LAS u32x4*)(lds + kdst + 64 * KP * 2) = gk1; *(LAS u32x4*)(lds + rdst) = gr; *(LAS u32x4*)(lds + vdst) = gv0; *(LAS u32x4*)(lds + vdst + 128) = gv1;
            __syncthreads();
            float m_run = -INFINITY, l_run = 0.f;
            f32x16 o0, o1;
#pragma unroll
            for (int r = 0; r < 16; ++r) { o0[r] = 0.f; o1[r] = 0.f; }
#define PREFETCH_NEXT() do { if (more) { const size_t ko = (size_t)(t + 1) * 128;                     const char* kb2 = kbase + ko * NKN * 2; const char* rb2 = rbase + ko * 64; const char* vb2 = vbase + ko * 2;                     gk0 = *(const u32x4*)(kb2 + koff); gk1 = *(const u32x4*)(kb2 + 64 * NKN * 2 + koff); gr = *(const u32x4*)(rb2 + roff); gv0 = *(const u32x4*)(vb2 + voff); gv1 = *(const u32x4*)(vb2 + 128 + voff); } } while (0)
            for (int t = 0; t < NT2; ++t) {
                const bool more = (t + 1 < NT2);
                const LAS unsigned char* buf = lds + (t & 1) * BUF;
                const LAS unsigned char* kA = buf + (pr * KP + 8 * hi) * 2; const LAS unsigned char* vA = buf + KBUF + (r32 * VP + 8 * hi) * 2;
                if (2 * t + 1 <= qc) {
                    bf16x8 kf[12], kf2[12], vf[8], vf2[8], pa[4], pb2[4]; f32x16 a0, a1, b0, b1;
                    attn_ldk(kf, kA);
                    __builtin_amdgcn_sched_barrier(0);
                    attn_qk(a0, a1, kf, qf);
                    attn_ldk(kf2, kA + 64 * KP * 2);
                    __builtin_amdgcn_sched_barrier(0);
                    attn_qk(b0, b1, kf2, qf);
                    attn_softmax(a0, a1, pa, o0, o1, m_run, l_run);
                    attn_ldv(vf, vA);
                    __builtin_amdgcn_sched_barrier(0);
                    PREFETCH_NEXT();
                    attn_ldv(vf2, vA + 128);
                    __builtin_amdgcn_sched_barrier(0);
                    attn_pv(vf, pa, o0, o1);
                    attn_softmax(b0, b1, pb2, o0, o1, m_run, l_run);
                    __builtin_amdgcn_sched_barrier(0);
                    attn_pv(vf2, pb2, o0, o1);
                } else if (2 * t <= qc) {
                    bf16x8 kf[12], vf[8], pa[4]; f32x16 a0, a1;
                    PREFETCH_NEXT();
                    attn_ldk(kf, kA);
                    __builtin_amdgcn_sched_barrier(0);
                    attn_qk(a0, a1, kf, qf);
                    __builtin_amdgcn_sched_barrier(0);
                    attn_ldv(vf, vA);
                    __builtin_amdgcn_sched_barrier(0);
                    attn_softmax(a0, a1, pa, o0, o1, m_run, l_run);
                    __builtin_amdgcn_sched_barrier(0);
                    attn_pv(vf, pa, o0, o1);
                } else { PREFETCH_NEXT(); }
                if (more) { LAS unsigned char* nb = lds + ((t + 1) & 1) * BUF;
                    *(LAS u32x4*)(nb + kdst) = gk0; *(LAS u32x4*)(nb + kdst + 64 * KP * 2) = gk1; *(LAS u32x4*)(nb + rdst) = gr; *(LAS u32x4*)(nb + vdst) = gv0; *(LAS u32x4*)(nb + vdst + 128) = gv1; }
                __syncthreads();
            }
            const float l = l_run + __shfl_xor(l_run, 32);
            const float inv = 1.0f / l;
            bf16_t* op = AO + (rowbase + qrow0 + r32) * DM + h * 64 + 8 * hi;
#pragma unroll
            for (int blk_ = 0; blk_ < 2; ++blk_) {
#pragma unroll
                for (int k2 = 0; k2 < 2; ++k2) {
                    const int g0 = 2 * k2, g1 = 2 * k2 + 1;
                    unsigned x0, x1, y0, y1;
                    if (blk_ == 0) { x0 = pk2(o0[4 * g0] * inv, o0[4 * g0 + 1] * inv); x1 = pk2(o0[4 * g0 + 2] * inv, o0[4 * g0 + 3] * inv); y0 = pk2(o0[4 * g1] * inv, o0[4 * g1 + 1] * inv); y1 = pk2(o0[4 * g1 + 2] * inv, o0[4 * g1 + 3] * inv); }
                    else           { x0 = pk2(o1[4 * g0] * inv, o1[4 * g0 + 1] * inv); x1 = pk2(o1[4 * g0 + 2] * inv, o1[4 * g0 + 3] * inv); y0 = pk2(o1[4 * g1] * inv, o1[4 * g1 + 1] * inv); y1 = pk2(o1[4 * g1 + 2] * inv, o1[4 * g1 + 3] * inv); }
                    const auto s0 = __builtin_amdgcn_permlane32_swap(x0, y0, false, false);
                    const auto s1 = __builtin_amdgcn_permlane32_swap(x1, y1, false, false);
                    u32x4 w; w.x = s0[0]; w.y = s1[0]; w.z = s0[1]; w.w = s1[1];
                    *(u32x4*)(op + 32 * blk_ + 16 * k2) = w;
                }
            }
        }
    }
    __builtin_amdgcn_s_setprio(0);
}

#undef PREFETCH_NEXT
__global__ void __launch_bounds__(512, 2) mega_fwd(Args a) {
    extern __shared__ __attribute__((aligned(16))) unsigned char lds_raw[];
    LAS unsigned char* lds = (LAS unsigned char*)lds_raw;
    cg::grid_group grid = cg::this_grid();
    if (threadIdx.x < 16) ((LAS unsigned*)(lds + 131072))[threadIdx.x] = 0u;
    __syncthreads();
    XcdBarrier xbar; { KARGS(); xbar = xcd_barrier_post((unsigned*)(KA->ws + WS_BAR), (volatile LAS unsigned*)(lds + 131072)); }
#define tid (otid())
#define lane (otid() & 63)
#define wave (__builtin_amdgcn_readfirstlane((int)(threadIdx.x >> 6)))
#define G ((int)gridDim.x)
#define bx ((int)blockIdx.x)
#define vcu ((G % 8 == 0) ? (bx % 8) * (G / 8) + bx / 8 : bx)
#define gw (vcu * 8 + wave)
#define NGW (G * 8)
#define gid (bx * 512 + tid)
#define NT_ALL (G * 512)
#define ws (KA->ws)
#define ADA ((float*)(ws + WS_ADA))
#define ROPE ((float*)(ws + WS_ROPE))
#define WSP ((bf16_t*)(ws + WS_WSP))
#define WIN ((bf16_t*)(ws + WS_WIN))
#define WUQ ((bf16_t*)(ws + WS_WUQ))
#define WUK ((bf16_t*)(ws + WS_WUK))
#define WUV ((bf16_t*)(ws + WS_WUV))
#define WO ((bf16_t*)(ws + WS_WO))
#define WUP ((bf16_t*)(ws + WS_WUP))
#define WDN ((bf16_t*)(ws + WS_WDN))
#define XN ((bf16_t*)(ws + WS_XN))
#define Z ((bf16_t*)(ws + WS_Z))
#define CQN ((bf16_t*)(ws + WS_CQN))
#define CKVN ((bf16_t*)(ws + WS_CKVN))
#define KR ((bf16_t*)(ws + WS_KR))
#define Q ((bf16_t*)(ws + WS_Q))
#define KN ((bf16_t*)(ws + WS_KN))
#define VT ((bf16_t*)(ws + WS_VT))
#define AO ((bf16_t*)(ws + WS_AO))
#define MB ((bf16_t*)(ws + WS_MB))
#define SIDE ((float*)(ws + WS_SIDE))
#define ACT ((bf16_t*)(ws + WS_ACT))
#define FB ((bf16_t*)(ws + WS_FB))
    { KARGS();
    {
        LAS float* cact = (LAS float*)lds;
        for (int i = tid; i < NB * DM; i += 512) cact[i] = silu_f(KA->c[i]);
        __syncthreads();
        for (int it = gw; it < 768; it += NGW) {
            const int cb = it % 24, kc = it / 24, n0 = cb * 256 + lane * 4, k0 = kc * 32;
            f32x4 acc[8];
#pragma unroll
            for (int b = 0; b < 8; ++b) acc[b] = (f32x4){0.f, 0.f, 0.f, 0.f};
#pragma unroll 8
            for (int kk = 0; kk < 32; ++kk) {
                const f32x4 w = *(const f32x4*)(KA->w_ada + (size_t)(k0 + kk) * 6144 + n0);
#pragma unroll
                for (int b = 0; b < 8; ++b) acc[b] += cact[b * DM + k0 + kk] * w;
            }
            if (kc == 0) { const f32x4 bv = *(const f32x4*)(KA->b_ada + n0);
#pragma unroll
                for (int b = 0; b < 8; ++b) acc[b] += bv; }
#pragma unroll
            for (int b = 0; b < 8; ++b)
#pragma unroll
                for (int e = 0; e < 4; ++e) __hip_atomic_fetch_add(ADA + b * 6144 + n0 + e, acc[b][e], __ATOMIC_RELAXED, __HIP_MEMORY_SCOPE_AGENT);
        }
        __syncthreads();
        LAS float* scr = (LAS float*)(lds + wave * 16384);
#pragma unroll 1
        for (int rep0_ = 0; rep0_ < (PROBE == 12 ? 2 : 1); ++rep0_) {
        constexpr int I_IN = 16 * 45, I_UQ = 4 * 24, I_UKV = 2 * 32, I_O = 16 * 32, I_UP = 16 * 176, I_DN = 44 * 32;
        constexpr int NITEMS = I_IN + I_UQ + I_UKV + I_O + I_UP + I_DN;
        for (int it = (gw + NGW - (768 % NGW)) % NGW; it < NITEMS; it += NGW) {
            int r = it;
            if (r < I_IN) { const int kb = r / 45, n0 = 32 * (r % 45); tr_item(KA->w_in, DM, 1440, WIN, 64 * kb, n0, n0 + (n0 >= 416 ? 96 : 0), scr, lane); continue; } r -= I_IN;
            if (r < I_UQ) { const int kb = r / 24, n0 = 32 * (r % 24); tr_item(KA->w_uq, QL, NQ, WUQ, 64 * kb, n0, n0, scr, lane); continue; } r -= I_UQ;
            if (r < I_UKV) { const int kb = r / 32, n0 = 32 * (r % 32); const int hh = n0 >> 7, q4 = (n0 & 127) >> 5;
                tr_item(KA->w_ukv, KVL, 1024, q4 < 2 ? WUK : WUV, 64 * kb, n0, hh * 64 + 32 * (q4 & 1), scr, lane); continue; } r -= I_UKV;
            if (r < I_O) { const int kb = r / 32, n0 = 32 * (r % 32); tr_item(KA->w_out, DM, DM, WO, 64 * kb, n0, n0, scr, lane); continue; } r -= I_O;
            if (r < I_UP) { const int kb = r / 176, n0 = 32 * (r % 176); const int isb = n0 >= DFF, j = isb ? n0 - DFF : n0;
                tr_item(KA->w_up, DM, NUP, WUP, 64 * kb, n0, 256 * (j >> 7) + 128 * isb + (j & 127), scr, lane, true); continue; } r -= I_UP;
            { const int kb = r / 32, n0 = 32 * (r % 32); tr_item(KA->w_down, DFF, DM, WDN, 64 * kb, n0, n0, scr, lane); }
        }
        for (int i = gid; i < 96 * 1024 / 8; i += NT_ALL) *(u32x4*)(WIN + (size_t)416 * 1024 + (size_t)i * 8) = (u32x4){0u, 0u, 0u, 0u};
        for (int i = gid; i < 8 * 128 * 128; i += NT_ALL) { const int ii = (i >> 7) & 127, jj = i & 127; const float v = ((jj >> 6) <= (ii >> 6)) ? KA->w_spatial[i] : 0.f; WSP[i] = (bf16_t)(pk2(v, 0.f) & 0xffffu); }
        for (int i = gid; i < SEQ * 16; i += NT_ALL) { const int s = i >> 4, f = i & 15;
            const float inv = exp2f(-(float)f * (13.287712379549449f / 16.0f));
            const float ang = (float)s * inv;
            const double rev = (double)ang * 0.15915494309189535; const float fr = (float)(rev - floor(rev));
            ROPE[2 * i] = __builtin_amdgcn_cosf(fr); ROPE[2 * i + 1] = __builtin_amdgcn_sinf(fr); }
        }
    }
    }
    { KARGS(); if (KA->out == nullptr) grid.sync(); }
    GSYNC();

    { KARGS();
    for (int idx = gid; idx < NB * DM; idx += NT_ALL) { const int b = idx >> 10, c = idx & 1023; const float* ad = ADA + b * 6144; float* gvp = (float*)(ws + WS_GV);
        gvp[idx] = KA->g_post_mix[c] * ad[2048 + c]; gvp[8192 + idx] = KA->g_pre_ffn[c] * (1.0f + ad[4096 + c]); gvp[16384 + idx] = ad[3072 + c]; gvp[24576 + idx] = KA->g_post_ffn[c] * ad[5120 + c]; }

#pragma unroll 1
    for (int rep_ = 0; rep_ < (PROBE == 7 ? 2 : 1); ++rep_) {
    for (int r0 = gw * 16; r0 < MTOK; r0 += NGW * 16) {
        const int b = r0 >> 12; const float* ad = ADA + b * 6144;
        f32x4 A1[4], B1[4];
#pragma unroll
        for (int j = 0; j < 4; ++j) { const int c = 4 * lane + 256 * j; const f32x4 g = *(const f32x4*)(KA->g_pre_mix + c), sc = *(const f32x4*)(ad + 1024 + c); A1[j] = g * (1.0f + sc); B1[j] = *(const f32x4*)(ad + c); }
        f32x4 vn[4];
#pragma unroll
        for (int j = 0; j < 4; ++j) vn[j] = __builtin_nontemporal_load((const f32x4*)(KA->x + (size_t)r0 * DM + 4 * lane + 256 * j));
        for (int rr = 0; rr < 16; ++rr) {
            const size_t row = (size_t)(r0 + rr), nrow = (size_t)(r0 + (rr < 15 ? rr + 1 : 15));
            f32x4 v[4]; float ss = 0.f;
#pragma unroll
            for (int j = 0; j < 4; ++j) { v[j] = vn[j]; vn[j] = __builtin_nontemporal_load((const f32x4*)(KA->x + nrow * DM + 4 * lane + 256 * j)); ss += (v[j][0] * v[j][0] + v[j][1] * v[j][1]) + (v[j][2] * v[j][2] + v[j][3] * v[j][3]); }
            const float rs = rsqrtf(wave_sum(ss) * (1.0f / DM) + EPS);
#pragma unroll
            for (int j = 0; j < 4; ++j) { const f32x4 o = v[j] * rs * A1[j] + B1[j]; u32x2 w; w.x = pk2(o[0], o[1]); w.y = pk2(o[2], o[3]); *(u32x2*)(XN + row * DM + 4 * lane + 256 * j) = w; }
        }
    }
    }
    }
    GSYNC();

    { KARGS();
#pragma unroll 1
    for (int rep_ = 0; rep_ < (PROBE == 10 ? 2 : 1); ++rep_) {
    { pg8::Gemm g{XN, WIN, MTOK, NZ, DM}; pg8::StaticOrder S; S.init(MTOK, NZ, G, bx); pg8::EpiZ2 E{Z, CQN, CKVN, KR, KA->g_q, KA->g_kv, ROPE, (LAS float*)(lds + 131072 + 1024)};
      pg8::gemm_phase<pg8::EpiZ2, pg8::StaticOrder, true, true>(lds, g, S, E); }
    }
    }
    GSYNC();

    { KARGS();
#pragma unroll 1
    for (int rep_ = 0; rep_ < (PROBE == 3 ? 2 : 1); ++rep_) {
    {
        constexpr int VLP = 136;
        LAS bf16_t* VLT = (LAS bf16_t*)lds;
        const int r32 = lane & 31, hi = lane >> 5, iblk = wave >> 1, dblk = wave & 1;
        const int jt = tid >> 2, qd = tid & 3;
        u32x4 r0, r1; f32x4 lgv[4], lbv[4];
        const int ustep = (G == 256) ? 1 : G;
        const int jx = vcu & 31;
        const int u0 = (G == 256) ? (256 * (vcu >> 5) + (jx < 16 ? 7 * jx : 112 + 9 * (jx - 16))) : vcu;
        const int ucnt = (G == 256) ? (bx < 128 ? 7 : 9) : (vcu < 2048 ? (2047 - vcu) / G + 1 : 0);
        if (ucnt > 0) { const bf16_t* vp = Z + ((size_t)(u0 >> 3) * 128 + jt) * NZ + 1024 + (u0 & 7) * 64 + 16 * qd; r0 = *(const u32x4*)vp; r1 = *(const u32x4*)(vp + 8);
#pragma unroll
            for (int e4 = 0; e4 < 4; ++e4) { lgv[e4] = *(const f32x4*)(KA->gm_ln_g + (u0 & 7) * 64 + 16 * qd + 4 * e4); lbv[e4] = *(const f32x4*)(KA->gm_ln_b + (u0 & 7) * 64 + 16 * qd + 4 * e4); } }
        for (int ui = 0, u = u0; ui < ucnt; ++ui, u += ustep) {
            const int blk = u >> 3, h = u & 7; const size_t t0 = (size_t)blk * 128;
            {
                float xv[16];
                xv[0] = bf_lo(r0.x); xv[1] = bf_hi(r0.x); xv[2] = bf_lo(r0.y); xv[3] = bf_hi(r0.y); xv[4] = bf_lo(r0.z); xv[5] = bf_hi(r0.z); xv[6] = bf_lo(r0.w); xv[7] = bf_hi(r0.w);
                xv[8] = bf_lo(r1.x); xv[9] = bf_hi(r1.x); xv[10] = bf_lo(r1.y); xv[11] = bf_hi(r1.y); xv[12] = bf_lo(r1.z); xv[13] = bf_hi(r1.z); xv[14] = bf_lo(r1.w); xv[15] = bf_hi(r1.w);
                float sm = 0.f;
#pragma unroll
                for (int e = 0; e < 16; ++e) sm += xv[e];
                sm += __shfl_xor(sm, 1); sm += __shfl_xor(sm, 2);
                const float mu = sm * (1.0f / 64.0f); float q = 0.f;
#pragma unroll
                for (int e = 0; e < 16; ++e) { xv[e] -= mu; q += xv[e] * xv[e]; }
                q += __shfl_xor(q, 1); q += __shfl_xor(q, 2);
                const float rstd = rsqrtf(q * (1.0f / 64.0f) + EPS);
#pragma unroll
                for (int e = 0; e < 16; ++e) { const float y = xv[e] * rstd * lgv[e >> 2][e & 3] + lbv[e >> 2][e & 3]; VLT[(16 * qd + e) * VLP + jt] = (bf16_t)(pk2(y, 0.f) & 0xffffu); }
            }
            const int un = u + ustep;
            if (ui + 1 < ucnt) { const bf16_t* vp = Z + ((size_t)(un >> 3) * 128 + jt) * NZ + 1024 + (un & 7) * 64 + 16 * qd; r0 = *(const u32x4*)vp; r1 = *(const u32x4*)(vp + 8);
#pragma unroll
                for (int e4 = 0; e4 < 4; ++e4) { lgv[e4] = *(const f32x4*)(KA->gm_ln_g + (un & 7) * 64 + 16 * qd + 4 * e4); lbv[e4] = *(const f32x4*)(KA->gm_ln_b + (un & 7) * 64 + 16 * qd + 4 * e4); } }
            const int itok = 32 * iblk + r32;
            const bf16_t* up = Z + (t0 + itok) * NZ + 512 + h * 64 + 32 * dblk + 4 * hi;
            u32x2 uu[4];
#pragma unroll
            for (int g = 0; g < 4; ++g) uu[g] = *(const u32x2*)(up + 8 * g);
            const float bsp = KA->b_spatial[h * 128 + itok];
            bf16x8 wf[8];
            { const bf16_t* wp = WSP + ((size_t)h * 128 + itok) * 128 + 8 * hi;
#pragma unroll
              for (int s = 0; s < 8; ++s) if (s < 4 || iblk >= 2) wf[s] = *(const bf16x8*)(wp + 16 * s); }
            __syncthreads();
            {
                f32x16 acc;
#pragma unroll
                for (int r = 0; r < 16; ++r) acc[r] = 0.f;
                const LAS bf16_t* vl = VLT + (32 * dblk + r32) * VLP + 8 * hi;
#pragma unroll
                for (int s = 0; s < 8; ++s) if (s < 4 || iblk >= 2) {
                    const bf16x8 vf = *(const LAS bf16x8*)(vl + 16 * s);
                    acc = __builtin_amdgcn_mfma_f32_32x32x16_bf16(vf, wf[s], acc, 0, 0, 0);
                }
                bf16_t* op = AO + (t0 + itok) * DM + 512 + h * 64 + 32 * dblk + 4 * hi;
#pragma unroll
                for (int g = 0; g < 4; ++g) {
                    u32x2 w; w.x = pk2(bf_lo(uu[g].x) * (acc[4 * g] + bsp), bf_hi(uu[g].x) * (acc[4 * g + 1] + bsp)); w.y = pk2(bf_lo(uu[g].y) * (acc[4 * g + 2] + bsp), bf_hi(uu[g].y) * (acc[4 * g + 3] + bsp));
                    *(u32x2*)(op + 8 * g) = w;
                }
            }
            __syncthreads();
        }
    }
    }
    }

    { KARGS();
#pragma unroll 1
    for (int rep_ = 0; rep_ < (PROBE == 4 ? 2 : 1); ++rep_) {
    { int Kh = QL; asm volatile("" : "+s"(Kh)); pg8::Gemm g{CQN, WUQ, MTOK, NQ, Kh}; pg8::StaticOrder S; S.init(MTOK, NQ, G, bx); pg8::EpiQ E{Q, ROPE};
      pg8::gemm_phase<pg8::EpiQ, pg8::StaticOrder, true, true>(lds, g, S, E); }
    }
    { KARGS();
    { int Kh = KVL; asm volatile("" : "+s"(Kh)); pg8::Gemm g{CKVN, WUK, MTOK, NKN, Kh}; pg8::StaticOrder S; S.init(MTOK, NKN, G, bx); pg8::EpiBf16 E{KN, NKN, 1 << 30};
      pg8::gemm_phase<pg8::EpiBf16, pg8::StaticOrder, true, true>(lds, g, S, E); }
    }
    { KARGS();
    { int Kh = KVL; asm volatile("" : "+s"(Kh)); pg8::Gemm g{WUV, CKVN, 512, MTOK, Kh}; pg8::StaticOrder S; S.init(512, MTOK, G, bx); pg8::EpiBf16 E{VT, MTOK, 1 << 30};
      pg8::gemm_phase<pg8::EpiBf16, pg8::StaticOrder, true, true>(lds, g, S, E); }
    }
    }
    GSYNC();

    { KARGS();
    attn_phase(lds, Q, KN, KR, VT, AO, vcu, G, tid, lane, wave);
#if PROBE == 2
    __syncthreads();
    attn_phase(lds, Q, KN, KR, VT, AO, vcu, G, tid, lane, wave);
#endif
    }
    GSYNC();

    if (G == 256) {
#pragma unroll 1
        for (int call = 0; call < 2; ++call) { KARGS();
            pg8::Gemm g{AO + (size_t)call * (MTOK / 2) * DM, WO, MTOK / 2, DM, DM}; pg8::StaticOrder S; S.init(MTOK / 2, DM, G, bx);
            pg8::PanelSS st1{(float*)(ws + WS_XB) + 1 * 131072, (unsigned*)(ws + WS_CNT) + 1 * 8192, 64 * call, EPS};
            pg8::PanelSS st2{(float*)(ws + WS_XB) + 2 * 131072, (unsigned*)(ws + WS_CNT) + 2 * 8192, 64 * call, EPS};
            pg8::Unit u0; u0.pm = 0; u0.pn = 0; (void)S.next(0, u0);
            const float* gvb = (const float*)(ws + WS_GV) + (call * 4 + (u0.pm >> 4)) * DM;
            pg8::EpiRmsResRms E2{KA->x, KA->out, XN, gvb, gvb + 8192, gvb + 16384, call * (MTOK / 2), st1, st2};
            pg8::gemm_phase<pg8::EpiRmsResRms, pg8::StaticOrder, false, true>(lds, g, S, E2); }
        GSYNC();
    } else {
    { KARGS();
#pragma unroll 1
    for (int rep_ = 0; rep_ < (PROBE == 8 ? 2 : 1); ++rep_) {
    { pg8::Gemm g{AO, WO, MTOK, DM, DM}; pg8::StaticOrder S; S.init(MTOK, DM, G, bx); pg8::EpiBf16 E{MB, DM, 1 << 30};
      pg8::gemm_phase<pg8::EpiBf16, pg8::StaticOrder, true, true>(lds, g, S, E); }
    }
    }
    GSYNC();

    { KARGS();
#pragma unroll 1
    for (int rep_ = 0; rep_ < (PROBE == 6 ? 2 : 1); ++rep_) {
    for (int r0 = gw * 16; r0 < MTOK; r0 += NGW * 16) {
        const int b = r0 >> 12; const float* ad = ADA + b * 6144;
        f32x4 G1[4], G2[4], S2[4];
#pragma unroll
        for (int j = 0; j < 4; ++j) { const int c = 4 * lane + 256 * j;
            G1[j] = *(const f32x4*)(KA->g_post_mix + c) * *(const f32x4*)(ad + 2048 + c);
            G2[j] = *(const f32x4*)(KA->g_pre_ffn + c) * (1.0f + *(const f32x4*)(ad + 4096 + c));
            S2[j] = *(const f32x4*)(ad + 3072 + c); }
        u32x2 mn[4]; f32x4 xn[4];
#pragma unroll
        for (int j = 0; j < 4; ++j) { mn[j] = *(const u32x2*)(MB + (size_t)r0 * DM + 4 * lane + 256 * j); xn[j] = *(const f32x4*)(KA->x + (size_t)r0 * DM + 4 * lane + 256 * j); }
        for (int rr = 0; rr < 16; ++rr) {
            const size_t row = (size_t)(r0 + rr), nrow = (size_t)(r0 + (rr < 15 ? rr + 1 : 15));
            f32x4 mv[4], xv[4]; float ss = 0.f;
#pragma unroll
            for (int j = 0; j < 4; ++j) { const u32x2 w = mn[j]; mv[j] = (f32x4){bf_lo(w.x), bf_hi(w.x), bf_lo(w.y), bf_hi(w.y)}; xv[j] = xn[j];
                mn[j] = *(const u32x2*)(MB + nrow * DM + 4 * lane + 256 * j); xn[j] = *(const f32x4*)(KA->x + nrow * DM + 4 * lane + 256 * j);
                ss += (mv[j][0] * mv[j][0] + mv[j][1] * mv[j][1]) + (mv[j][2] * mv[j][2] + mv[j][3] * mv[j][3]); }
            const float rs = rsqrtf(wave_sum(ss) * (1.0f / DM) + EPS);
            float s2 = 0.f;
#pragma unroll
            for (int j = 0; j < 4; ++j) { xv[j] = xv[j] + mv[j] * rs * G1[j]; *(f32x4*)(KA->out + row * DM + 4 * lane + 256 * j) = xv[j];
                s2 += (xv[j][0] * xv[j][0] + xv[j][1] * xv[j][1]) + (xv[j][2] * xv[j][2] + xv[j][3] * xv[j][3]); }
            const float r2 = rsqrtf(wave_sum(s2) * (1.0f / DM) + EPS);
#pragma unroll
            for (int j = 0; j < 4; ++j) { const f32x4 o = xv[j] * r2 * G2[j] + S2[j]; u32x2 w; w.x = pk2(o[0], o[1]); w.y = pk2(o[2], o[3]); *(u32x2*)(XN + row * DM + 4 * lane + 256 * j) = w; }
        }
    }
    }
    }
    GSYNC();
    }

    { KARGS();
#pragma unroll 1
    for (int rep_ = 0; rep_ < (PROBE == 9 ? 2 : 1); ++rep_) {
    { pg8::Gemm g{XN, WUP, MTOK, NUP, DM}; pg8::StaticOrder S; S.init(MTOK, NUP, G, bx); pg8::EpiConv E{ACT, SIDE, KA->conv_w, KA->conv_b, (LAS float*)(lds + 131072 + 1024)};
      pg8::gemm_phase<pg8::EpiConv, pg8::StaticOrder, true, true>(lds, g, S, E); }
    }
    }
    GSYNC();

    { KARGS();
    for (int idx = gid; idx < 128 * DFF; idx += NT_ALL) {
        const int pm = idx / DFF, j = idx - pm * DFF;
        if ((pm & 15) == 0) continue;
        const float* sp = SIDE + ((size_t)((pm - 1) * 4 + 2) * 2) * DFF + j;
        const float* sc = SIDE + ((size_t)(pm * 4 + 0) * 2) * DFF + j;
        const float p2a = sp[0], p2b = sp[DFF], p1a = sp[2 * DFF], p1b = sp[3 * DFF], x0a = sc[0], x0b = sc[DFF], x1a = sc[2 * DFF], x1b = sc[3 * DFF];
        const float wa0 = KA->conv_w[j], wa1 = KA->conv_w[NUP + j], wa2 = KA->conv_w[2 * NUP + j], wb0 = KA->conv_w[DFF + j], wb1 = KA->conv_w[NUP + DFF + j], wb2 = KA->conv_w[2 * NUP + DFF + j];
        const float ba = KA->conv_b[j], bb = KA->conv_b[DFF + j];
        const float ya0 = ba + wa0 * p2a + wa1 * p1a + wa2 * x0a, ya1 = ba + wa0 * p1a + wa1 * x0a + wa2 * x1a;
        const float yb0 = bb + wb0 * p2b + wb1 * p1b + wb2 * x0b, yb1 = bb + wb0 * p1b + wb1 * x0b + wb2 * x1b;
        ACT[(size_t)(pm * 256) * DFF + j] = (bf16_t)(pk2(silu_f(ya0) * yb0, 0.f) & 0xffffu);
        ACT[(size_t)(pm * 256 + 1) * DFF + j] = (bf16_t)(pk2(silu_f(ya1) * yb1, 0.f) & 0xffffu);
    }
    }
    GSYNC();

    if (G == 256) {
#pragma unroll 1
        for (int call = 0; call < 2; ++call) { KARGS();
            pg8::Gemm g{ACT + (size_t)call * (MTOK / 2) * DFF, WDN, MTOK / 2, DM, DFF}; pg8::StaticOrder S; S.init(MTOK / 2, DM, G, bx);
            pg8::PanelSS st{(float*)(ws + WS_XB), (unsigned*)(ws + WS_CNT), 64 * call, EPS};
            pg8::Unit u0; u0.pm = 0; u0.pn = 0; (void)S.next(0, u0);
            pg8::EpiRmsRes E2{KA->out, KA->out, (const float*)(ws + WS_GV) + 24576 + (call * 4 + (u0.pm >> 4)) * DM, call * (MTOK / 2), st};
            pg8::gemm_phase<pg8::EpiRmsRes, pg8::StaticOrder, false, true>(lds, g, S, E2); }
    } else {
    { KARGS();
#pragma unroll 1
    for (int rep_ = 0; rep_ < (PROBE == 11 ? 2 : 1); ++rep_) {
    { pg8::Gemm g{ACT, WDN, MTOK, DM, DFF}; pg8::StaticOrder S; S.init(MTOK, DM, G, bx); pg8::EpiBf16 E{FB, DM, 1 << 30};
      pg8::gemm_phase<pg8::EpiBf16, pg8::StaticOrder, true, true>(lds, g, S, E); }
    }
    }
    GSYNC();

    { KARGS();
    for (int r0 = gw * 16; r0 < MTOK; r0 += NGW * 16) {
        const int b = r0 >> 12; const float* ad = ADA + b * 6144;
        f32x4 G3[4];
#pragma unroll
        for (int j = 0; j < 4; ++j) { const int c = 4 * lane + 256 * j; G3[j] = *(const f32x4*)(KA->g_post_ffn + c) * *(const f32x4*)(ad + 5120 + c); }
        u32x2 fn[4]; f32x4 xn[4];
#pragma unroll
        for (int j = 0; j < 4; ++j) { fn[j] = *(const u32x2*)(FB + (size_t)r0 * DM + 4 * lane + 256 * j); xn[j] = *(const f32x4*)(KA->out + (size_t)r0 * DM + 4 * lane + 256 * j); }
        for (int rr = 0; rr < 16; ++rr) {
            const size_t row = (size_t)(r0 + rr); const bool last = (rr == 15); const size_t nrow = (size_t)(r0 + (last ? 15 : rr + 1));
            f32x4 fv[4], x1[4]; float ss = 0.f;
#pragma unroll
            for (int j = 0; j < 4; ++j) { const u32x2 w = fn[j]; fv[j] = (f32x4){bf_lo(w.x), bf_hi(w.x), bf_lo(w.y), bf_hi(w.y)}; x1[j] = xn[j];
                if (!last) { fn[j] = *(const u32x2*)(FB + nrow * DM + 4 * lane + 256 * j); xn[j] = *(const f32x4*)(KA->out + nrow * DM + 4 * lane + 256 * j); }
                ss += (fv[j][0] * fv[j][0] + fv[j][1] * fv[j][1]) + (fv[j][2] * fv[j][2] + fv[j][3] * fv[j][3]); }
            const float rs = rsqrtf(wave_sum(ss) * (1.0f / DM) + EPS);
#pragma unroll
            for (int j = 0; j < 4; ++j) *(f32x4*)(KA->out + row * DM + 4 * lane + 256 * j) = x1[j] + fv[j] * rs * G3[j];
        }
    }
    }
    }
}

#undef tid
#undef lane
#undef wave
#undef G
#undef bx
#undef vcu
#undef gw
#undef NGW
#undef gid
#undef NT_ALL
#undef ws
#undef ADA
#undef ROPE
#undef WSP
#undef WIN
#undef WUQ
#undef WUK
#undef WUV
#undef WO
#undef WUP
#undef WDN
#undef XN
#undef Z
#undef CQN
#undef CKVN
#undef KR
#undef Q
#undef KN
#undef VT
#undef AO
#undef MB
#undef SIDE
#undef ACT
#undef FB
extern "C" void kernel_launch(void* const* d_in, const int* in_sizes, int n_in, void* d_out, int out_size, void* d_ws, size_t ws_size, hipStream_t stream) {
    static int grid = 0;
    if (grid == 0) {
        if (n_in != 22 || ws_size < WS_END) { fprintf(stderr, "kernel_launch: unexpected inputs (n_in %d, ws %zu)\n", n_in, ws_size); grid = -1; return; }
        int dev = 0, cus = 0, per_cu = 0;
        (void)hipGetDevice(&dev); (void)hipDeviceGetAttribute(&cus, hipDeviceAttributeMultiprocessorCount, dev);
        (void)hipFuncSetAttribute((const void*)mega_fwd, hipFuncAttributeMaxDynamicSharedMemorySize, LDS_BYTES);
        if (hipOccupancyMaxActiveBlocksPerMultiprocessor(&per_cu, (const void*)mega_fwd, 512, LDS_BYTES) != hipSuccess || per_cu < 1) per_cu = 1;
        (void)hipGetLastError();
        grid = cus * per_cu; if (grid <= 0) grid = 256;
    }
    if (grid < 0) return;
    (void)hipMemsetAsync((char*)d_ws + WS_ADA, 0, CTL_ZERO_BYTES, stream);
    Args a{};
    const float** ap = (const float**)&a;
    for (int i = 0; i < 22; ++i) ap[i] = (const float*)d_in[i];
    a.out = (float*)d_out; a.ws = (unsigned char*)d_ws;
    void* args[] = {&a};
    hipError_t e = hipLaunchCooperativeKernel((const void*)mega_fwd, dim3(grid), dim3(512), args, LDS_BYTES, stream);
    if (e != hipSuccess) fprintf(stderr, "cooperative launch failed: %s (grid %d)\n", hipGetErrorString(e), grid);
}
```
